# Optimizing an MI355X kernel written in HIP

```python
import math
import jax, jax.numpy as jnp
from jax import lax
import numpy as np

D_MODEL = 1024
BATCH = 4
SEQ = 4096
DEPTH = 4

HEAD_DIM = 64
SWA_HEADS = 8
SWA_KV_HEADS = 2
SWA_GROUP = SWA_HEADS // SWA_KV_HEADS
WINDOW = 128
DIFF_HEADS = 4
DIFF_VDIM = 2 * HEAD_DIM
BLOCK = 128
D_FF = 2816
CONV_WIDTH = 3
RMS_EPS = 1e-6
NEG_INF = -1e30

SWA_Q = SWA_HEADS * HEAD_DIM
SWA_KV = SWA_KV_HEADS * HEAD_DIM
DIFF_QK = DIFF_HEADS * 2 * HEAD_DIM
DIFF_V = DIFF_HEADS * DIFF_VDIM
IN_COLS = SWA_Q + 2 * SWA_KV + 2 * DIFF_QK + DIFF_V + 2 * D_MODEL

kernel_name = "hybrid_swa_sink_diffattn_alibi_convffn_adaln"


def _rmsnorm(x, g):
    xf = x.astype(jnp.float32)
    y = xf * lax.rsqrt(jnp.mean(xf * xf, axis=-1, keepdims=True) + RMS_EPS)
    return (y * g.astype(jnp.float32)).astype(x.dtype)


def _alibi_slopes(n):
    return jnp.array([2.0 ** (-8.0 * (i + 1) / n) for i in range(n)], dtype=jnp.float32)


def _sliding_window_attention(q, k, v, sinks, slopes):
    b, s, _, d = q.shape
    nb = s // BLOCK
    qb = q.reshape(b, nb, BLOCK, SWA_KV_HEADS, SWA_GROUP, d)

    def with_prev(t):
        tb = t.reshape(b, nb, BLOCK, SWA_KV_HEADS, d)
        prev = jnp.concatenate([jnp.zeros_like(tb[:, :1]), tb[:, :-1]], axis=1)
        return jnp.concatenate([prev, tb], axis=2)

    kb, vb = with_prev(k), with_prev(v)
    scores = jnp.einsum('bnqkgd,bnskd->bnkgqs', qb, kb).astype(jnp.float32) * (d ** -0.5)
    qi = jnp.arange(BLOCK)[:, None]
    kj = jnp.arange(2 * BLOCK)[None, :]
    delta = qi + BLOCK - kj
    key_pos = jnp.arange(nb)[:, None, None] * BLOCK - BLOCK + kj[None]
    valid = (delta >= 0) & (delta < WINDOW) & (key_pos >= 0)
    bias = -slopes[:, :, None, None] * delta.astype(jnp.float32)
    scores = jnp.where(valid[None, :, None, None], scores + bias, NEG_INF)
    sink = jnp.broadcast_to(sinks.astype(jnp.float32).reshape(SWA_KV_HEADS, SWA_GROUP, 1, 1),
                            scores.shape[:-1] + (1,))
    probs = jax.nn.softmax(jnp.concatenate([scores, sink], axis=-1), axis=-1)[..., :-1]
    out = jnp.einsum('bnkgqs,bnskd->bnqkgd', probs.astype(v.dtype), vb)
    return out.reshape(b, s, SWA_HEADS * d)


def _diff_attention(q, k, v, lam, lam_init, subln_g, slopes):
    b, s = q.shape[:2]
    nb = s // BLOCK
    qb = jnp.moveaxis(q.reshape(b, nb, BLOCK, DIFF_HEADS, 2, HEAD_DIM), 1, 0)
    key_pos = jnp.arange(s)
    scale = HEAD_DIM ** -0.5

    def block_fn(args):
        qblk, n = args
        scores = jnp.einsum('bqhmd,bshmd->bhmqs', qblk, k).astype(jnp.float32) * scale
        q_pos = n * BLOCK + jnp.arange(BLOCK)
        delta = q_pos[:, None] - key_pos[None, :]
        scores = scores - slopes[:, None, None, None] * delta.astype(jnp.float32)
        scores = jnp.where(delta >= 0, scores, NEG_INF)
        p = jax.nn.softmax(scores, axis=-1)
        a = p[:, :, 0] - lam * p[:, :, 1]
        return jnp.einsum('bhqs,bshe->bqhe', a.astype(v.dtype), v)

    out = lax.map(block_fn, (qb, jnp.arange(nb)))
    out = jnp.moveaxis(out, 0, 1).reshape(b, s, DIFF_HEADS, DIFF_VDIM)
    out = _rmsnorm(out, subln_g) * (1.0 - lam_init)
    return out.reshape(b, s, DIFF_V)


def _conv_ffn(h, w_up, conv_w, conv_b, w_down):
    u = h @ w_up
    a, g = jnp.split(u, 2, axis=-1)
    s = a.shape[1]
    ap = jnp.pad(a, ((0, 0), (CONV_WIDTH - 1, 0), (0, 0)))
    a = ap[:, 0:s] * conv_w[0] + ap[:, 1:s + 1] * conv_w[1] + ap[:, 2:s + 2] * conv_w[2] + conv_b
    return (jax.nn.gelu(a, approximate=False) * g) @ w_down


def setup_inputs(seed: int = 0) -> dict:
    key = jax.random.key(seed)
    ks = jax.random.split(key, 20)
    nrm = lambda k, shape, s: jax.random.normal(k, shape, jnp.float32) * s
    D = D_MODEL
    return {
        "x": nrm(ks[0], (BATCH, SEQ, D), 1.0),
        "c": nrm(ks[1], (BATCH, D), 1.0),
        "w_ada": nrm(ks[2], (DEPTH, D, 6 * D), 0.5 * D ** -0.5),
        "b_ada": nrm(ks[3], (DEPTH, 6 * D), 0.02),
        "norm1_g": 1.0 + nrm(ks[4], (DEPTH, D), 0.02),
        "w_in": nrm(ks[5], (DEPTH, D, IN_COLS), D ** -0.5),
        "swa_sinks": nrm(ks[6], (DEPTH, SWA_HEADS), 1.0),
        "diff_lambda": nrm(ks[7], (DEPTH, 4, HEAD_DIM), 0.1),
        "diff_subln_g": 1.0 + nrm(ks[8], (DEPTH, DIFF_VDIM), 0.02),
        "w_branch_swa": nrm(ks[9], (DEPTH, SWA_Q, D), SWA_Q ** -0.5),
        "w_branch_diff": nrm(ks[10], (DEPTH, DIFF_V, D), DIFF_V ** -0.5),
        "w_out": nrm(ks[11], (DEPTH, D, D), D ** -0.5),
        "norm2_g": 1.0 + nrm(ks[12], (DEPTH, D), 0.02),
        "w_up": nrm(ks[13], (DEPTH, D, 2 * D_FF), D ** -0.5),
        "conv_w": nrm(ks[14], (DEPTH, CONV_WIDTH, D_FF), CONV_WIDTH ** -0.5),
        "conv_b": nrm(ks[15], (DEPTH, D_FF), 0.02),
        "w_down": nrm(ks[16], (DEPTH, D_FF, D), D_FF ** -0.5),
        "final_g": 1.0 + nrm(ks[17], (D,), 0.02),
    }


def reference(x, c, w_ada, b_ada, norm1_g, w_in, swa_sinks, diff_lambda, diff_subln_g,
              w_branch_swa, w_branch_diff, w_out, norm2_g, w_up, conv_w, conv_b, w_down, final_g):
    b, s, _ = x.shape
    sizes = [SWA_Q, SWA_KV, SWA_KV, DIFF_QK, DIFF_QK, DIFF_V, D_MODEL, D_MODEL]
    points = [int(p) for p in np.cumsum(sizes)[:-1]]
    slopes_swa = _alibi_slopes(SWA_HEADS).reshape(SWA_KV_HEADS, SWA_GROUP)
    slopes_diff = _alibi_slopes(DIFF_HEADS)
    cs = jax.nn.silu(c)
    for l in range(DEPTH):
        mod = cs @ w_ada[l] + b_ada[l]
        shift1, scale1, gate1, shift2, scale2, gate2 = [m[:, None, :] for m in jnp.split(mod, 6, axis=-1)]

        h = _rmsnorm(x, norm1_g[l]) * (1.0 + scale1) + shift1
        proj = h @ w_in[l]
        qa, ka, va, qd, kd, vd, ga, gd = jnp.split(proj, points, axis=-1)
        out_a = _sliding_window_attention(
            qa.reshape(b, s, SWA_HEADS, HEAD_DIM),
            ka.reshape(b, s, SWA_KV_HEADS, HEAD_DIM),
            va.reshape(b, s, SWA_KV_HEADS, HEAD_DIM),
            swa_sinks[l], slopes_swa)
        lam_init = 0.8 - 0.6 * math.exp(-0.3 * l)
        lp = diff_lambda[l].astype(jnp.float32)
        lam = jnp.exp(jnp.sum(lp[0] * lp[1])) - jnp.exp(jnp.sum(lp[2] * lp[3])) + lam_init
        out_d = _diff_attention(
            qd.reshape(b, s, DIFF_HEADS, 2, HEAD_DIM),
            kd.reshape(b, s, DIFF_HEADS, 2, HEAD_DIM),
            vd.reshape(b, s, DIFF_HEADS, DIFF_VDIM),
            lam, lam_init, diff_subln_g[l], slopes_diff)
        merged = (jax.nn.sigmoid(ga) * (out_a @ w_branch_swa[l])
                  + jax.nn.sigmoid(gd) * (out_d @ w_branch_diff[l]))
        x = x + gate1 * (merged @ w_out[l])

        h2 = _rmsnorm(x, norm2_g[l]) * (1.0 + scale2) + shift2
        x = x + gate2 * _conv_ffn(h2, w_up[l], conv_w[l], conv_b[l], w_down[l])
    return _rmsnorm(x, final_g)
```

```cpp
#include <hip/hip_runtime.h>
#include <hip/hip_cooperative_groups.h>
#include <cstdio>
#include <cstdint>
#include <cstddef>
namespace cg = cooperative_groups;

#define LAS __attribute__((address_space(3)))
typedef unsigned short bf16_t;
typedef short bf16x8 __attribute__((ext_vector_type(8)));
typedef float f32x4 __attribute__((ext_vector_type(4)));
typedef float f32x2 __attribute__((ext_vector_type(2)));
typedef float f32x16 __attribute__((ext_vector_type(16)));
typedef unsigned u32x4 __attribute__((ext_vector_type(4)));
typedef unsigned u32x2 __attribute__((ext_vector_type(2)));

constexpr int DM = 1024, NBATCH = 4, SEQ = 4096, NTOK = NBATCH * SEQ, DEPTH = 4;
constexpr int INC = 4352, DFF = 2816, UPN = 2 * DFF;
constexpr int C_QA = 0, C_KA = 512, C_VA = 640, C_QD = 768, C_KD = 1280, C_VD = 1792, C_GA = 2304, C_GD = 3328;
constexpr float LOG2E = 1.4426950408889634f;
constexpr float QSCALE = 0.125f * LOG2E;
constexpr float RMS_EPS = 1e-6f;
constexpr int UP_MT = 17;

constexpr size_t MiB = 1u << 20;
constexpr size_t WS_LAM = 0;
constexpr size_t WS_MOD = 64 * 1024;
constexpr size_t WS_W = 2 * MiB;
constexpr size_t W_IN = 0, W_BR = (size_t)INC * DM * 2, W_OUT = W_BR + (size_t)DM * DM * 2, W_UP = W_OUT + (size_t)DM * DM * 2,
                 W_DN = W_UP + (size_t)UPN * DM * 2, W_LAYER = W_DN + (size_t)DM * DFF * 2;
static_assert(W_LAYER == 29 * MiB, "weights per layer");
constexpr size_t WS_H = 120 * MiB;
constexpr size_t WS_O = 152 * MiB;
constexpr size_t WS_MG = 184 * MiB;
constexpr size_t WS_PROJ = 216 * MiB;
constexpr size_t WS_ACT = WS_PROJ;
constexpr size_t WS_END = 352 * MiB;
static_assert(WS_PROJ + (size_t)NTOK * INC * 2 <= WS_END, "ws map");

constexpr int RING_BYTES = 131072;
constexpr int HALO_OFF = RING_BYTES;
constexpr int LDS_BYTES = RING_BYTES + 8192;

__device__ __forceinline__ unsigned cvt_pk_bf16(float lo, float hi) { unsigned r; asm volatile("v_cvt_pk_bf16_f32 %0, %1, %2" : "=v"(r) : "v"(lo), "v"(hi)); return r; }
__device__ __forceinline__ float bf_lo(unsigned w) { return __builtin_bit_cast(float, w << 16); }
__device__ __forceinline__ float bf_hi(unsigned w) { return __builtin_bit_cast(float, w & 0xffff0000u); }
__device__ __forceinline__ float fast_exp2(float x) { return __builtin_amdgcn_exp2f(x); }
__device__ __forceinline__ float fast_rcp(float x) { return __builtin_amdgcn_rcpf(x); }
__device__ __forceinline__ float sigmoidf_(float x) { return fast_rcp(1.0f + fast_exp2(-x * LOG2E)); }

namespace pg8 {
constexpr int BM = 256, BK = 64, HALF = 128, HTB = HALF * BK * 2, STAGE_BYTES = 8 * HTB, NXCD = 8, WGM = 8;
__host__ __device__ __forceinline__ int lds_byte(int r, int c) { const int st = (r >> 4) * 2 + (c >> 5), rr = r & 15, cc = c & 31, ob = rr * 64 + cc * 2; return st * 1024 + (ob ^ (((ob >> 9) & 1) << 5)); }
__host__ __device__ __forceinline__ void stage_rc(int b, int& R, int& C) { const int st = b / 1024, sb = b % 1024, swz = sb ^ (((sb >> 9) & 1) << 5); R = (st >> 1) * 16 + swz / 64; C = (st & 1) * 32 + (swz % 64) / 2; }
__host__ __device__ __forceinline__ int perm32(int rho) { const int n = rho >> 4, i = rho & 15; return 8 * (i >> 2) + 4 * n + (i & 3); }

struct Unit { int pm, pn, arow, koff, half; };
struct Gemm { const bf16_t* A; const bf16_t* Bt; int lda, ldb, K; };

struct StaticOrder {
    int nM, nN, nwg, G, c, mode;
    __device__ void init(int nM_, int nN_, int G_, int c_, int mode_) { nM = nM_; nN = nN_; nwg = nM * nN; G = G_; c = c_; mode = mode_; }
    __device__ bool next(int i, Unit& u) const {
        const int ti = (mode == 2) ? (i >> 1) : i;
        const long L = (long)ti * G + c; if (L >= nwg) return false;
        int wgid = (int)L; { const int q = nwg / NXCD, r = nwg % NXCD, xcd = wgid % NXCD, off = wgid / NXCD; wgid = (xcd < r ? xcd * (q + 1) : r * (q + 1) + (xcd - r) * q) + off; }
        const int nig = WGM * nN, gid = wgid / nig, fm = gid * WGM, gsz = (nM - fm) < WGM ? (nM - fm) : WGM;
        u.pm = fm + ((wgid % nig) % gsz); u.pn = (wgid % nig) / gsz;
        u.arow = (mode != 1) ? u.pm * BM : (u.pm / UP_MT) * SEQ + 254 * (u.pm % UP_MT) - 2;
        u.half = (mode == 2) ? (i & 1) : 1; u.koff = (mode == 2) ? (i & 1) * 512 : 0;
        return true;
    }
};

template <class Epi, class Sched, bool ALIGN_EPI = true, bool SP2 = true>
__device__ __forceinline__ void gemm_phase(LAS unsigned char* lds, const Gemm g, const Sched& S, const Epi& E) {
    int tid_ = threadIdx.x; asm volatile("" : "+v"(tid_));
    const int tid = tid_, wid = __builtin_amdgcn_readfirstlane(tid >> 6), lane = tid & 63, wr = wid >> 2, wc = wid & 3, fr = lane & 15, fq = lane >> 4;
    const int K = g.K, nt = K / BK;
    unsigned voffA[2], voffB[2];
#pragma unroll
    for (int i = 0; i < 2; ++i) { int R, C; stage_rc(tid * 16 + i * 8192, R, C); const int Rb = Epi::PERM ? ((R & ~31) + perm32(R & 31)) : R;
        voffA[i] = (unsigned)(R * g.lda + C) * 2u; voffB[i] = (unsigned)(Rb * g.ldb + C) * 2u; }
    const size_t kstep = (size_t)(BK * 2);
    const size_t hstepA = (size_t)HALF * g.lda * 2, hstepB = (size_t)HALF * g.ldb * 2;
    const unsigned ldsw = (unsigned)wid * 1024u;
    const int aoff = lds_byte(wr * 64 + fr, fq * 8), boff = lds_byte(wc * 32 + fr, fq * 8);
#define PG8_SA(b, h) (((b) * 2 + (h)) * HTB)
#define PG8_SB(b, h) ((4 + (b) * 2 + (h)) * HTB)
#define PG8_STAGE(bufoff, gbase, voff) do { _Pragma("unroll") for (int _i = 0; _i < 2; ++_i) \
        __builtin_amdgcn_global_load_lds((const unsigned*)((const char*)(gbase) + (voff)[_i]), (LAS unsigned*)(lds + (bufoff) + ldsw + _i * 8192), 16, 0, 0); } while (0)
#define PG8_LDA(dst, b, h) do { _Pragma("unroll") for (int m = 0; m < 4; ++m) _Pragma("unroll") for (int k = 0; k < 2; ++k) dst[m][k] = *(const LAS bf16x8*)(lds + PG8_SA(b, h) + aoff + m * 2048 + k * 1024); } while (0)
#define PG8_LDB(dst, b, h) do { _Pragma("unroll") for (int n = 0; n < 2; ++n) _Pragma("unroll") for (int k = 0; k < 2; ++k) dst[n][k] = *(const LAS bf16x8*)(lds + PG8_SB(b, h) + boff + n * 2048 + k * 1024); } while (0)
#define PG8_MMA(ai, bj, At, Bt) do { __builtin_amdgcn_s_setprio(1); _Pragma("unroll") for (int m = 0; m < 4; ++m) _Pragma("unroll") for (int n = 0; n < 2; ++n) _Pragma("unroll") for (int k = 0; k < 2; ++k) \
        acc[ai][bj][m][n] = __builtin_amdgcn_mfma_f32_16x16x32_bf16(Bt[n][k], At[m][k], acc[ai][bj][m][n], 0, 0, 0); __builtin_amdgcn_s_setprio(0); } while (0)
#define PG8_WAIT_V(n) asm volatile("s_waitcnt vmcnt(" #n ")" ::: "memory")
#define PG8_WAIT_L(n) asm volatile("s_waitcnt lgkmcnt(" #n ")" ::: "memory")
#define PG8_BAR __builtin_amdgcn_s_barrier()
#define PG8_SCHED __builtin_amdgcn_sched_barrier(0)
    Unit cur, nxt; int ui = 0;
    if (!S.next(0, cur)) return;
    f32x4 acc[2][2][4][2];
#pragma unroll
    for (int a = 0; a < 2; ++a)
#pragma unroll
        for (int b = 0; b < 2; ++b)
#pragma unroll
            for (int m = 0; m < 4; ++m)
#pragma unroll
                for (int n = 0; n < 2; ++n) acc[a][b][m][n] = (f32x4){0.f, 0.f, 0.f, 0.f};
    bf16x8 At[4][2], B0[2][2], B1[2][2];
    const char* cA = (const char*)g.A + (ptrdiff_t)cur.arow * g.lda * 2 + cur.koff * 2; const char* cB = (const char*)g.Bt + (size_t)cur.pn * 2 * hstepB + cur.koff * 2;
    {
        PG8_STAGE(PG8_SB(0, 0), cB, voffB); PG8_STAGE(PG8_SB(0, 1), cB + hstepB, voffB); PG8_STAGE(PG8_SA(0, 0), cA, voffA); PG8_STAGE(PG8_SA(0, 1), cA + hstepA, voffA);
        if (wr == 1) PG8_BAR;
        PG8_WAIT_V(2); PG8_BAR;
        PG8_STAGE(PG8_SB(1, 0), cB + kstep, voffB); PG8_STAGE(PG8_SA(1, 0), cA + kstep, voffA); PG8_STAGE(PG8_SB(1, 1), cB + hstepB + kstep, voffB);
        PG8_WAIT_V(6); PG8_BAR;
    }
    for (;;) {
        const bool has_next = S.next(ui + 1, nxt);
        const char* nA = has_next ? (const char*)g.A + (ptrdiff_t)nxt.arow * g.lda * 2 + nxt.koff * 2 : cA; const char* nB = has_next ? (const char*)g.Bt + (size_t)nxt.pn * 2 * hstepB + nxt.koff * 2 : cB;
        for (int t = 0; t < nt; t += 2) {
            const bool last = (t == nt - 2);
            const char* a1 = cA + (size_t)(t + 1) * kstep;
            const char* a2 = last ? nA : cA + (size_t)(t + 2) * kstep; const char* b2 = last ? nB : cB + (size_t)(t + 2) * kstep;
            const char* a3 = a2 + kstep; const char* b3 = b2 + kstep;
            PG8_LDB(B0, 0, 0); PG8_LDB(B1, 0, 1); PG8_SCHED; PG8_LDA(At, 0, 0); PG8_STAGE(PG8_SA(1, 1), a1 + hstepA, voffA);
            PG8_WAIT_V(8); PG8_WAIT_L(0); PG8_BAR; PG8_MMA(0, 0, At, B0); PG8_MMA(0, 1, At, B1); PG8_BAR; PG8_SCHED;
            PG8_LDA(At, 0, 1); PG8_STAGE(PG8_SB(0, 0), b2, voffB); PG8_STAGE(PG8_SB(0, 1), b2 + hstepB, voffB); PG8_STAGE(PG8_SA(0, 0), a2, voffA);
            PG8_WAIT_V(8); PG8_WAIT_L(0); PG8_BAR; PG8_MMA(1, 0, At, B0); PG8_MMA(1, 1, At, B1); PG8_BAR; PG8_SCHED;
            PG8_LDB(B0, 1, 0); PG8_LDB(B1, 1, 1); PG8_SCHED; PG8_LDA(At, 1, 0); PG8_STAGE(PG8_SA(0, 1), a2 + hstepA, voffA);
            PG8_WAIT_V(8); PG8_WAIT_L(0); PG8_BAR; PG8_MMA(0, 0, At, B0); PG8_MMA(0, 1, At, B1); PG8_BAR; PG8_SCHED;
            PG8_LDA(At, 1, 1); PG8_STAGE(PG8_SB(1, 0), b3, voffB); PG8_STAGE(PG8_SB(1, 1), b3 + hstepB, voffB); PG8_STAGE(PG8_SA(1, 0), a3, voffA);
            PG8_WAIT_V(8); PG8_WAIT_L(0); PG8_BAR; PG8_MMA(1, 0, At, B0); PG8_MMA(1, 1, At, B1); PG8_BAR; PG8_SCHED;
        }
        if constexpr (ALIGN_EPI) { if (wr == 0) PG8_BAR; }
        if constexpr (Epi::HAS_MID) { if (cur.half == 0) E.mid(acc, cur, wr, wc, fr, fq); else E(acc, cur, wr, wc, fr, fq); }
        else E(acc, cur, wr, wc, fr, fq);
        if (!has_next) break;
        if (!(Epi::HAS_MID && cur.half == 0)) {
#pragma unroll
        for (int a = 0; a < 2; ++a)
#pragma unroll
            for (int b = 0; b < 2; ++b)
#pragma unroll
                for (int m = 0; m < 4; ++m)
#pragma unroll
                    for (int n = 0; n < 2; ++n) acc[a][b][m][n] = (f32x4){0.f, 0.f, 0.f, 0.f};
        }
        cur = nxt; cA = nA; cB = nB; ++ui;
        if constexpr (ALIGN_EPI) { if (wr == 1) PG8_BAR; }
    }
    PG8_WAIT_V(0);
    if constexpr (!ALIGN_EPI) { if (wr == 0) PG8_BAR; }
    PG8_BAR;
#undef PG8_SA
#undef PG8_SB
#undef PG8_STAGE
#undef PG8_LDA
#undef PG8_LDB
#undef PG8_MMA
#undef PG8_WAIT_V
#undef PG8_WAIT_L
#undef PG8_BAR
#undef PG8_SCHED
}

__device__ __forceinline__ f32x2 gelu_pk(f32x2 v) {
    const f32x2 av = __builtin_elementwise_abs(v), d = av * 0.2316418882f + 1.0f;
    f32x2 t; t.x = __builtin_amdgcn_rcpf(d.x); t.y = __builtin_amdgcn_rcpf(d.y);
    f32x2 q = t * 0.5307027145f + (-0.7265760135f); q = q * t + 0.7107068705f; q = q * t + (-0.142248368f); q = q * t + 0.127414796f; q = q * t;
    const f32x2 s = (v * v) * (-0.72134752044f);
    f32x2 e; e.x = __builtin_amdgcn_exp2f(s.x); e.y = __builtin_amdgcn_exp2f(s.y);
    const f32x2 m = v * (q * e), r = v - m;
    f32x2 o; o.x = v.x < 0.f ? m.x : r.x; o.y = v.y < 0.f ? m.y : r.y; return o;
}


struct EpiInProj {
    static constexpr bool PERM = true, HAS_MID = false;
    bf16_t* O;
    __device__ __forceinline__ void operator()(const f32x4 (&acc)[2][2][4][2], const Unit& u, int wr, int wc, int fr, int fq) const {
        const int row0 = u.pm * BM + wr * 64 + fr;
#pragma unroll
        for (int bj = 0; bj < 2; ++bj) {
            const int colg = u.pn * BM + bj * HALF;
            const int kind = (colg < C_KA || (colg >= C_QD && colg < C_KD)) ? 1 : (colg >= C_GA ? 2 : 0);
            bf16_t* base = O + colg + wc * 32 + 8 * fq;
#pragma unroll
            for (int ai = 0; ai < 2; ++ai)
#pragma unroll
                for (int m = 0; m < 4; ++m) {
                    f32x4 v0 = acc[ai][bj][m][0], v1 = acc[ai][bj][m][1];
                    if (kind == 1) { v0 = v0 * QSCALE; v1 = v1 * QSCALE; }
                    else if (kind == 2) {
#pragma unroll
                        for (int j = 0; j < 4; ++j) { v0[j] = sigmoidf_(v0[j]); v1[j] = sigmoidf_(v1[j]); }
                    }
                    u32x4 w; w.x = cvt_pk_bf16(v0[0], v0[1]); w.y = cvt_pk_bf16(v0[2], v0[3]); w.z = cvt_pk_bf16(v1[0], v1[1]); w.w = cvt_pk_bf16(v1[2], v1[3]);
                    *(u32x4*)(base + (size_t)(row0 + ai * HALF + m * 16) * INC) = w;
                }
        }
    }
};

struct EpiMerge {
    static constexpr bool PERM = true, HAS_MID = true;
    const bf16_t* P; bf16_t* O;
    __device__ __forceinline__ void mid(f32x4 (&acc)[2][2][4][2], const Unit& u, int wr, int wc, int fr, int fq) const {
        const int row0 = u.pm * BM + wr * 64 + fr;
#pragma unroll
        for (int ai = 0; ai < 2; ++ai)
#pragma unroll
            for (int m = 0; m < 4; ++m) {
                const bf16_t* rp = P + (size_t)(row0 + ai * HALF + m * 16) * INC + u.pn * BM + wc * 32 + 8 * fq;
#pragma unroll
                for (int bj = 0; bj < 2; ++bj) {
                    const u32x4 ga = *(const u32x4*)(rp + C_GA + bj * HALF), gd = *(const u32x4*)(rp + C_GD + bj * HALF);
                    f32x4 r0, r1;
                    r0[0] = bf_lo(ga.x) * fast_rcp(bf_lo(gd.x)); r0[1] = bf_hi(ga.x) * fast_rcp(bf_hi(gd.x)); r0[2] = bf_lo(ga.y) * fast_rcp(bf_lo(gd.y)); r0[3] = bf_hi(ga.y) * fast_rcp(bf_hi(gd.y));
                    r1[0] = bf_lo(ga.z) * fast_rcp(bf_lo(gd.z)); r1[1] = bf_hi(ga.z) * fast_rcp(bf_hi(gd.z)); r1[2] = bf_lo(ga.w) * fast_rcp(bf_lo(gd.w)); r1[3] = bf_hi(ga.w) * fast_rcp(bf_hi(gd.w));
                    acc[ai][bj][m][0] = acc[ai][bj][m][0] * r0; acc[ai][bj][m][1] = acc[ai][bj][m][1] * r1;
                }
                asm volatile("" : "+v"(acc[ai][0][m][0]), "+v"(acc[ai][0][m][1]), "+v"(acc[ai][1][m][0]), "+v"(acc[ai][1][m][1]) :: "memory");
            }
    }
    __device__ __forceinline__ void operator()(const f32x4 (&acc)[2][2][4][2], const Unit& u, int wr, int wc, int fr, int fq) const {
        const int row0 = u.pm * BM + wr * 64 + fr;
#pragma unroll
        for (int ai = 0; ai < 2; ++ai)
#pragma unroll
            for (int m = 0; m < 4; ++m) {
                const size_t row = (size_t)(row0 + ai * HALF + m * 16);
                const int col = u.pn * BM + wc * 32 + 8 * fq;
#pragma unroll
                for (int bj = 0; bj < 2; ++bj) {
                    const u32x4 gd = *(const u32x4*)(P + row * INC + C_GD + col + bj * HALF);
                    const f32x4 v0 = acc[ai][bj][m][0], v1 = acc[ai][bj][m][1];
                    u32x4 w; w.x = cvt_pk_bf16(v0[0] * bf_lo(gd.x), v0[1] * bf_hi(gd.x)); w.y = cvt_pk_bf16(v0[2] * bf_lo(gd.y), v0[3] * bf_hi(gd.y));
                    w.z = cvt_pk_bf16(v1[0] * bf_lo(gd.z), v1[1] * bf_hi(gd.z)); w.w = cvt_pk_bf16(v1[2] * bf_lo(gd.w), v1[3] * bf_hi(gd.w));
                    *(u32x4*)(O + row * DM + col + bj * HALF) = w;
                }
            }
    }
};

struct EpiRes {
    static constexpr bool PERM = false, HAS_MID = false;
    const float* in; float* out; const float* gate;
    __device__ __forceinline__ void operator()(const f32x4 (&acc)[2][2][4][2], const Unit& u, int wr, int wc, int fr, int fq) const {
        const int col0 = u.pn * BM + wc * 32 + 4 * fq; const int b = (u.pm * BM) / SEQ;
        f32x4 gv[2][2];
#pragma unroll
        for (int bj = 0; bj < 2; ++bj)
#pragma unroll
            for (int n = 0; n < 2; ++n) gv[bj][n] = *(const f32x4*)(gate + (size_t)b * 6 * DM + col0 + bj * HALF + n * 16);
#pragma unroll
        for (int ai = 0; ai < 2; ++ai)
#pragma unroll
            for (int m = 0; m < 4; ++m) { const size_t off = (size_t)(u.pm * BM + ai * HALF + wr * 64 + m * 16 + fr) * DM + col0;
#pragma unroll
                for (int bj = 0; bj < 2; ++bj)
#pragma unroll
                    for (int n = 0; n < 2; ++n) { const f32x4 bs = *(const f32x4*)(in + off + bj * HALF + n * 16);
                        *(f32x4*)(out + off + bj * HALF + n * 16) = bs + gv[bj][n] * acc[ai][bj][m][n]; }
            }
    }
};

__device__ __forceinline__ float dpp_ror1(float v) { return __builtin_bit_cast(float, __builtin_amdgcn_update_dpp(0, __builtin_bit_cast(int, v), 0x121, 0xf, 0xf, false)); }
__device__ __forceinline__ float dpp_ror2(float v) { return __builtin_bit_cast(float, __builtin_amdgcn_update_dpp(0, __builtin_bit_cast(int, v), 0x122, 0xf, 0xf, false)); }

struct EpiUp {
    static constexpr bool PERM = true, HAS_MID = false;
    bf16_t* ACT; const float* cw; const float* cb; LAS float* halo;
    __device__ __forceinline__ void operator()(f32x4 (&acc)[2][2][4][2], const Unit& u, int wr, int wc, int fr, int fq) const {
        const int b = u.pm / UP_MT, i = u.pm % UP_MT, pos0 = 254 * i - 2;
        const int lc = wc * 32 + 8 * fq;
        const int cbase = u.pn * HALF + lc;
        if (i == 0 && wr == 0 && fr < 2) { acc[0][0][0][0] = (f32x4){0.f, 0.f, 0.f, 0.f}; acc[0][0][0][1] = (f32x4){0.f, 0.f, 0.f, 0.f}; }
        if (fr >= 14) {
#pragma unroll
            for (int ai = 0; ai < 2; ++ai)
#pragma unroll
                for (int n = 0; n < 2; ++n) *(LAS f32x4*)(halo + ((ai * 2 + wr) * 2 + (fr - 14)) * HALF + lc + 4 * n) = acc[ai][0][3][n];
        }
        asm volatile("s_waitcnt lgkmcnt(0)" ::: "memory"); __builtin_amdgcn_s_barrier(); asm volatile("" ::: "memory");
#pragma unroll
        for (int n = 0; n < 2; ++n) {
            const f32x4 w0 = *(const f32x4*)(cw + cbase + 4 * n), w1 = *(const f32x4*)(cw + DFF + cbase + 4 * n),
                        w2 = *(const f32x4*)(cw + 2 * DFF + cbase + 4 * n), bv = *(const f32x4*)(cb + cbase + 4 * n);
#pragma unroll
            for (int ai = 0; ai < 2; ++ai)
#pragma unroll
                for (int m = 0; m < 4; ++m) {
                    const f32x4 cur = acc[ai][0][m][n];
                    f32x4 p1, p2;
                    if (m > 0) {
                        const f32x4 pr = acc[ai][0][m - 1][n];
#pragma unroll
                        for (int j = 0; j < 4; ++j) { const float r1 = dpp_ror1(cur[j]), r2 = dpp_ror2(cur[j]), q1 = dpp_ror1(pr[j]), q2 = dpp_ror2(pr[j]);
                            p1[j] = fr >= 1 ? r1 : q1; p2[j] = fr >= 2 ? r2 : q2; }
                    } else {
                        f32x4 h0 = (f32x4){0.f, 0.f, 0.f, 0.f}, h1 = h0;
                        if (!(ai == 0 && wr == 0)) { const int sidx = (wr == 1) ? (ai * 2) : ((ai - 1) * 2 + 1);
                            h0 = *(const LAS f32x4*)(halo + (sidx * 2 + 0) * HALF + lc + 4 * n); h1 = *(const LAS f32x4*)(halo + (sidx * 2 + 1) * HALF + lc + 4 * n); }
#pragma unroll
                        for (int j = 0; j < 4; ++j) { const float r1 = dpp_ror1(cur[j]), r2 = dpp_ror2(cur[j]);
                            p1[j] = fr >= 1 ? r1 : h1[j]; p2[j] = fr >= 2 ? r2 : (fr == 1 ? h1[j] : h0[j]); }
                    }
                    const f32x4 a = p2 * w0 + p1 * w1 + cur * w2 + bv;
                    const f32x2 g0 = gelu_pk((f32x2){a[0], a[1]}), g1 = gelu_pk((f32x2){a[2], a[3]});
                    const f32x4 gg = acc[ai][1][m][n];
                    const int tr = ai * HALF + wr * 64 + m * 16 + fr, p = pos0 + tr;
                    if (tr >= 2 && p < SEQ) {
                        u32x2 w; w.x = cvt_pk_bf16(g0.x * gg[0], g0.y * gg[1]); w.y = cvt_pk_bf16(g1.x * gg[2], g1.y * gg[3]);
                        *(u32x2*)(ACT + (size_t)(b * SEQ + p) * DFF + cbase + 4 * n) = w;
                    }
                }
        }
    }
};
}

namespace att {
typedef short v4i16 __attribute__((ext_vector_type(4)));
__device__ __forceinline__ f32x16 mfma32(bf16x8 a, bf16x8 b, f32x16 c) { return __builtin_amdgcn_mfma_f32_32x32x16_bf16(a, b, c, 0, 0, 0); }
__device__ __forceinline__ v4i16 vtr(const LAS char* p) { return __builtin_amdgcn_ds_read_tr16_b64_v4i16((LAS v4i16*)p); }
__device__ __forceinline__ int klocal(int r, int hi) { return 8 * (r >> 2) + 4 * hi + (r & 3); }

template <int NDB> struct St { f32x16 O[NDB]; float M, l; };

template <int NDB>
__device__ __forceinline__ void step(St<NDB>& s, const bf16x8 (&qf)[4], const f32x16& cval, float c32, float T,
                                     const LAS char* Kl, int KP, const LAS char* Vl, int VP, int krow, int nb, int mask0, int mask1, int lane) {
    const int l32 = lane & 31, hi = lane >> 5;
    const float NEG = -__builtin_inff();
    f32x16 x0 = cval, x1;
    const LAS char* kp = Kl + (krow + l32) * KP + hi * 16;
#pragma unroll
    for (int ks = 0; ks < 4; ++ks) x0 = mfma32(*(const LAS bf16x8*)(kp + ks * 32), qf[ks], x0);
    if (nb == 2) {
        x1 = cval;
#pragma unroll
        for (int ks = 0; ks < 4; ++ks) x1 = mfma32(*(const LAS bf16x8*)(kp + 32 * KP + ks * 32), qf[ks], x1);
#pragma unroll
        for (int r = 0; r < 16; ++r) x1[r] += c32;
    } else {
#pragma unroll
        for (int r = 0; r < 16; ++r) x1[r] = NEG;
    }
    if (mask0 == 1) {
#pragma unroll
        for (int r = 0; r < 16; ++r) if (klocal(r, hi) > l32) x0[r] = NEG;
    } else if (mask0 == 2) {
#pragma unroll
        for (int r = 0; r < 16; ++r) if (klocal(r, hi) <= l32) x0[r] = NEG;
    }
    if (mask1 == 1) {
#pragma unroll
        for (int r = 0; r < 16; ++r) if (klocal(r, hi) > l32) x1[r] = NEG;
    }
    float mx = x0[0];
#pragma unroll
    for (int r = 1; r < 16; ++r) mx = fmaxf(mx, x0[r]);
#pragma unroll
    for (int r = 0; r < 16; ++r) mx = fmaxf(mx, x1[r]);
    mx = fmaxf(mx, __shfl_xor(mx, 32));
    const float Mn = fmaxf(s.M, mx + T), alpha = fast_exp2(s.M - Mn), mrel = Mn - T;
    s.M = Mn;
    float sum = 0.f;
#pragma unroll
    for (int r = 0; r < 16; ++r) { x0[r] = fast_exp2(x0[r] - mrel); sum += x0[r]; }
#pragma unroll
    for (int r = 0; r < 16; ++r) { x1[r] = fast_exp2(x1[r] - mrel); sum += x1[r]; }
    s.l = s.l * alpha + sum;
#pragma unroll
    for (int db = 0; db < NDB; ++db) s.O[db] = s.O[db] * alpha;
    const int qd = (lane & 15) >> 2, blk = (lane >> 4) & 1, pp = lane & 3;
    const LAS char* vp = Vl + (krow + 4 * hi + qd) * VP + (16 * blk + 4 * pp) * 2;
#pragma unroll
    for (int kb = 0; kb < 2; ++kb) {
        if (kb == 1 && nb != 2) break;
#pragma unroll
        for (int ks2 = 0; ks2 < 2; ++ks2) {
            u32x4 pw;
            if (kb == 0) { pw.x = cvt_pk_bf16(x0[8 * ks2 + 0], x0[8 * ks2 + 1]); pw.y = cvt_pk_bf16(x0[8 * ks2 + 2], x0[8 * ks2 + 3]); pw.z = cvt_pk_bf16(x0[8 * ks2 + 4], x0[8 * ks2 + 5]); pw.w = cvt_pk_bf16(x0[8 * ks2 + 6], x0[8 * ks2 + 7]); }
            else         { pw.x = cvt_pk_bf16(x1[8 * ks2 + 0], x1[8 * ks2 + 1]); pw.y = cvt_pk_bf16(x1[8 * ks2 + 2], x1[8 * ks2 + 3]); pw.z = cvt_pk_bf16(x1[8 * ks2 + 4], x1[8 * ks2 + 5]); pw.w = cvt_pk_bf16(x1[8 * ks2 + 6], x1[8 * ks2 + 7]); }
            const bf16x8 pf = __builtin_bit_cast(bf16x8, pw);
            const LAS char* vr = vp + (32 * kb + 16 * ks2) * VP;
#pragma unroll
            for (int db = 0; db < NDB; ++db) {
                const v4i16 lo = vtr(vr + db * 64), hh = vtr(vr + 8 * VP + db * 64);
                const bf16x8 vf = (bf16x8){lo[0], lo[1], lo[2], lo[3], hh[0], hh[1], hh[2], hh[3]};
                s.O[db] = mfma32(vf, pf, s.O[db]);
            }
            __builtin_amdgcn_sched_barrier(0);
        }
    }
}

constexpr int DKP = 272, DVP = 320, DKB = 64 * DKP, DVB = 64 * DVP, DV0 = 2 * DKB;
__device__ __forceinline__ void diff_unit(const bf16_t* PROJ, bf16_t* OUT, int b, int h, int qblk, float lam, float post, const float* subg, LAS char* lds) {
    int tid_ = threadIdx.x; asm volatile("" : "+v"(tid_));
    const int tid = tid_, lane = tid & 63, wave = __builtin_amdgcn_readfirstlane(tid >> 6), l32 = lane & 31, hi = lane >> 5;
    const int map = wave >> 2, qs = wave & 3, q0 = qblk * 128, qw0 = q0 + 32 * qs;
    const float slope2 = exp2f(-2.0f * (float)(h + 1)) * LOG2E, c32 = 32.f * slope2;
    f32x16 cval;
#pragma unroll
    for (int r = 0; r < 16; ++r) cval[r] = slope2 * (float)klocal(r, hi);
    bf16x8 qf[4];
    { const bf16_t* qp = PROJ + (size_t)(b * SEQ + qw0 + l32) * INC + C_QD + h * 128 + map * 64 + hi * 8;
#pragma unroll
      for (int ks = 0; ks < 4; ++ks) qf[ks] = *(const bf16x8*)(qp + ks * 16); }
    St<4> s;
#pragma unroll
    for (int db = 0; db < 4; ++db)
#pragma unroll
        for (int r = 0; r < 16; ++r) s.O[db][r] = 0.f;
    s.M = -1e30f; s.l = 0.f;
    const int ntiles = 2 * qblk + 2;
    const int lrow = tid >> 4, lch = tid & 15;
    const bf16_t* kg = PROJ + (size_t)(b * SEQ + lrow) * INC + C_KD + h * 128 + lch * 8;
    const bf16_t* vg = PROJ + (size_t)(b * SEQ + lrow) * INC + C_VD + h * 128 + lch * 8;
    u32x4 kr[2], vr[2];
#pragma unroll
    for (int i = 0; i < 2; ++i) { kr[i] = *(const u32x4*)(kg + (size_t)(32 * i) * INC); vr[i] = *(const u32x4*)(vg + (size_t)(32 * i) * INC); }
#pragma unroll
    for (int i = 0; i < 2; ++i) { *(LAS u32x4*)(lds + (lrow + 32 * i) * DKP + lch * 16) = kr[i]; *(LAS u32x4*)(lds + DV0 + (lrow + 32 * i) * DVP + lch * 16) = vr[i]; }
    __syncthreads();
    for (int kt = 0; kt < ntiles; ++kt) {
        const int cb = kt & 1, nbuf = cb ^ 1;
        const bool more = (kt + 1 < ntiles);
        if (more) {
#pragma unroll
            for (int i = 0; i < 2; ++i) { kr[i] = *(const u32x4*)(kg + (size_t)(64 * (kt + 1) + 32 * i) * INC); vr[i] = *(const u32x4*)(vg + (size_t)(64 * (kt + 1) + 32 * i) * INC); }
        }
        const int k0 = 64 * kt;
        const int nb = (k0 > qw0) ? 0 : ((k0 + 32 > qw0) ? 1 : 2);
        if (nb > 0) {
            const int m0 = (k0 == qw0) ? 1 : 0, m1 = (k0 + 32 == qw0) ? 1 : 0;
            step<4>(s, qf, cval, c32, slope2 * (float)(k0 - qw0), lds + cb * DKB + map * 128, DKP, lds + DV0 + cb * DVB, DVP, 0, nb, m0, m1, lane);
        }
        if (more) {
#pragma unroll
            for (int i = 0; i < 2; ++i) { *(LAS u32x4*)(lds + nbuf * DKB + (lrow + 32 * i) * DKP + lch * 16) = kr[i]; *(LAS u32x4*)(lds + DV0 + nbuf * DVB + (lrow + 32 * i) * DVP + lch * 16) = vr[i]; }
        }
        __syncthreads();
    }
    const float lt = s.l + __shfl_xor(s.l, 32), inv = 1.0f / lt;
    LAS float* xch = (LAS float*)lds;
    if (map == 1) {
        const float f = inv * lam;
#pragma unroll
        for (int db = 0; db < 4; ++db)
#pragma unroll
            for (int r = 0; r < 16; ++r) xch[(qs * 64 + db * 16 + r) * 64 + lane] = s.O[db][r] * f;
    }
    __syncthreads();
    if (map == 0) {
        float ss = 0.f;
#pragma unroll
        for (int db = 0; db < 4; ++db)
#pragma unroll
            for (int r = 0; r < 16; ++r) { const float v = s.O[db][r] * inv - xch[(qs * 64 + db * 16 + r) * 64 + lane]; s.O[db][r] = v; ss += v * v; }
        ss += __shfl_xor(ss, 32);
        const float rs = rsqrtf(ss * (1.0f / 128.0f) + RMS_EPS) * post;
        bf16_t* op = OUT + (size_t)(b * SEQ + qw0 + l32) * DM + 512 + h * 128;
#pragma unroll
        for (int db = 0; db < 4; ++db)
#pragma unroll
            for (int g4 = 0; g4 < 4; ++g4) {
                const int d0 = 32 * db + 8 * g4 + 4 * hi;
                const f32x4 gv = *(const f32x4*)(subg + d0);
                u32x2 w; w.x = cvt_pk_bf16(s.O[db][4 * g4 + 0] * rs * gv[0], s.O[db][4 * g4 + 1] * rs * gv[1]);
                w.y = cvt_pk_bf16(s.O[db][4 * g4 + 2] * rs * gv[2], s.O[db][4 * g4 + 3] * rs * gv[3]);
                *(u32x2*)(op + d0) = w;
            }
    }
    __syncthreads();
}

constexpr int SKP = 144, SVP = 192, SV0 = 256 * SKP;
__device__ __forceinline__ void swa_unit(const bf16_t* PROJ, bf16_t* OUT, int b, int kvh, int n, const float* sinks, LAS char* lds) {
    int tid_ = threadIdx.x; asm volatile("" : "+v"(tid_));
    const int tid = tid_, lane = tid & 63, wave = __builtin_amdgcn_readfirstlane(tid >> 6), l32 = lane & 31, hi = lane >> 5;
    {
        const int ch = tid & 7, r0 = tid >> 3;
#pragma unroll
        for (int i = 0; i < 4; ++i) {
            const int row = r0 + 64 * i, pos = n * 128 - 128 + row;
            if (pos >= 0) {
                const bf16_t* src = PROJ + (size_t)(b * SEQ + pos) * INC + kvh * 64 + ch * 8;
                const u32x4 kv = *(const u32x4*)(src + C_KA), vv = *(const u32x4*)(src + C_VA);
                *(LAS u32x4*)(lds + row * SKP + ch * 16) = kv; *(LAS u32x4*)(lds + SV0 + row * SVP + ch * 16) = vv;
            }
        }
    }
    __syncthreads();
    for (int task = wave; task < 16; task += 8) {
        const int g = task >> 2, sb = task & 3, hq = kvh * 4 + g;
        const float slope2 = exp2f(-(float)(hq + 1)) * LOG2E, c32 = 32.f * slope2;
        f32x16 cval;
#pragma unroll
        for (int r = 0; r < 16; ++r) cval[r] = slope2 * (float)klocal(r, hi);
        bf16x8 qf[4];
        const size_t tok = (size_t)(b * SEQ + n * 128 + 32 * sb + l32);
        { const bf16_t* qp = PROJ + tok * INC + C_QA + hq * 64 + hi * 8;
#pragma unroll
          for (int ks = 0; ks < 4; ++ks) qf[ks] = *(const bf16x8*)(qp + ks * 16); }
        St<2> s;
#pragma unroll
        for (int db = 0; db < 2; ++db)
#pragma unroll
            for (int r = 0; r < 16; ++r) s.O[db][r] = 0.f;
        s.M = -1e30f; s.l = 0.f;
        const int kb_lo = (n == 0) ? 4 : sb, kb_hi = sb + 4;
        for (int kb = kb_lo; kb <= kb_hi; kb += 2) {
            const int nb = (kb + 1 <= kb_hi) ? 2 : 1;
            const int m0 = (kb == sb) ? 2 : ((kb == kb_hi) ? 1 : 0), m1 = (kb + 1 == kb_hi) ? 1 : 0;
            step<2>(s, qf, cval, c32, slope2 * (float)(32 * kb - (128 + 32 * sb)), lds, SKP, lds + SV0, SVP, 32 * kb, nb, m0, m1, lane);
        }
        const float sk = fast_exp2(sinks[hq] * LOG2E + slope2 * (float)l32 - s.M);
        const float lt = s.l + __shfl_xor(s.l, 32) + sk, inv = 1.0f / lt;
        bf16_t* op = OUT + tok * DM + hq * 64;
#pragma unroll
        for (int db = 0; db < 2; ++db)
#pragma unroll
            for (int g4 = 0; g4 < 4; ++g4) {
                const int d0 = 32 * db + 8 * g4 + 4 * hi;
                u32x2 w; w.x = cvt_pk_bf16(s.O[db][4 * g4 + 0] * inv, s.O[db][4 * g4 + 1] * inv); w.y = cvt_pk_bf16(s.O[db][4 * g4 + 2] * inv, s.O[db][4 * g4 + 3] * inv);
                *(u32x2*)(op + d0) = w;
            }
    }
    __syncthreads();
}
}

struct Params {
    const float *x, *c, *w_ada, *b_ada, *norm1_g, *w_in, *sinks, *dlam, *subg, *w_bs, *w_bd, *w_out, *norm2_g, *w_up, *conv_w, *conv_b, *w_down, *final_g;
    float* out; unsigned char* ws;
    int ph_lo, ph_hi;
};

__device__ __forceinline__ float wave_sum(float v) {
#pragma unroll
    for (int o = 1; o < 64; o <<= 1) v += __shfl_xor(v, o);
    return v;
}
__device__ __forceinline__ unsigned f2bf(float f) { unsigned u = __builtin_bit_cast(unsigned, f); return (u + 0x7fffu + ((u >> 16) & 1u)) >> 16; }
__device__ __forceinline__ unsigned pk2(float lo, float hi) { return f2bf(lo) | (f2bf(hi) << 16); }

__device__ __forceinline__ void transpose_item(const float* W, int ldw, int k0, int n0, bf16_t* WT, int ldt, int drow0, int kcol0, LAS float* scr, int lane) {
#pragma unroll 8
    for (int i = 0; i < 32; ++i) { const int kk = 2 * i + (lane >> 5); scr[kk * 33 + (lane & 31)] = W[(size_t)(k0 + kk) * ldw + n0 + (lane & 31)]; }
    asm volatile("s_waitcnt lgkmcnt(0)" ::: "memory");
    const int c = lane & 7;
#pragma unroll
    for (int j = 0; j < 4; ++j) { const int n = (lane >> 3) + 8 * j; const LAS float* s = scr + (8 * c) * 33 + n;
        u32x4 o; o.x = pk2(s[0 * 33], s[1 * 33]); o.y = pk2(s[2 * 33], s[3 * 33]); o.z = pk2(s[4 * 33], s[5 * 33]); o.w = pk2(s[6 * 33], s[7 * 33]);
        *(u32x4*)(WT + (size_t)(drow0 + n) * ldt + kcol0 + 8 * c) = o; }
    asm volatile("s_waitcnt lgkmcnt(0)" ::: "memory");
}

__device__ __forceinline__ void norm_phase(const float* xin, bf16_t* H, const float* g, const float* shift, const float* scale, int gw, int ngw, int lane) {
    asm volatile("" : "+v"(lane));
    for (int chunk = gw; chunk < NTOK / 8; chunk += ngw) {
        const int m0 = chunk * 8, b = m0 / SEQ;
        f32x4 G[4], Sv[4];
#pragma unroll
        for (int j = 0; j < 4; ++j) { const int k = 4 * lane + 256 * j; const f32x4 gg = *(const f32x4*)(g + k), sc = *(const f32x4*)(scale + (size_t)b * 6 * DM + k);
            G[j] = gg * (sc + 1.0f); Sv[j] = *(const f32x4*)(shift + (size_t)b * 6 * DM + k); }
        for (int rr = 0; rr < 8; ++rr) {
            const float* xr = xin + (size_t)(m0 + rr) * DM;
            f32x4 v[4]; float ss = 0.f;
#pragma unroll
            for (int j = 0; j < 4; ++j) { v[j] = *(const f32x4*)(xr + 4 * lane + 256 * j); ss += (v[j].x * v[j].x + v[j].y * v[j].y) + (v[j].z * v[j].z + v[j].w * v[j].w); }
            const float rstd = rsqrtf(wave_sum(ss) * (1.0f / DM) + RMS_EPS);
            bf16_t* hr = H + (size_t)(m0 + rr) * DM;
#pragma unroll
            for (int j = 0; j < 4; ++j) { const f32x4 o = v[j] * rstd * G[j] + Sv[j]; u32x2 w; w.x = cvt_pk_bf16(o[0], o[1]); w.y = cvt_pk_bf16(o[2], o[3]); *(u32x2*)(hr + 4 * lane + 256 * j) = w; }
        }
    }
}

__global__ void __launch_bounds__(512) fwd_mega(Params p) {
    extern __shared__ __attribute__((aligned(16))) unsigned char lds_raw[];
    LAS unsigned char* lds = (LAS unsigned char*)lds_raw;
    cg::grid_group grid = cg::this_grid();
    const int tid = threadIdx.x, lane = tid & 63, wave = __builtin_amdgcn_readfirstlane(tid >> 6);
    const int G = gridDim.x, bid = blockIdx.x;
    const int gw = bid * 8 + wave, ngw = G * 8;
    unsigned char* ws = p.ws;
    float* lamv = (float*)(ws + WS_LAM);
    float* mod = (float*)(ws + WS_MOD);
    bf16_t* Hb = (bf16_t*)(ws + WS_H); bf16_t* Ob = (bf16_t*)(ws + WS_O); bf16_t* MGb = (bf16_t*)(ws + WS_MG);
    bf16_t* PROJ = (bf16_t*)(ws + WS_PROJ); bf16_t* ACT = (bf16_t*)(ws + WS_ACT);
    float* X = p.out;
    int phase = 0;
#define RUN(k) (p.ph_lo <= (k) && (k) < p.ph_hi)
#define SEAM(k) do { if (RUN(k) && RUN((k) + 1)) grid.sync(); } while (0)

    if (RUN(phase)) {
        if (bid == 0 && tid < DEPTH) {
            const float* lp = p.dlam + tid * 4 * 64; float s1 = 0.f, s2 = 0.f;
            for (int i = 0; i < 64; ++i) { s1 += lp[i] * lp[64 + i]; s2 += lp[128 + i] * lp[192 + i]; }
            lamv[tid] = expf(s1) - expf(s2) + (0.8f - 0.6f * expf(-0.3f * (float)tid));
        }
        {
            LAS float* cs = (LAS float*)lds;
            LAS float* red = (LAS float*)(lds + 16384);
            for (int i = tid; i < NBATCH * DM; i += 512) { const float v = p.c[i]; cs[i] = v / (1.0f + expf(-v)); }
            __syncthreads();
            for (int it = bid; it < DEPTH * 96; it += G) {
                const int l = it / 96, j0 = (it % 96) * 64;
                const float* wp = p.w_ada + (size_t)l * DM * 6 * DM + (size_t)(128 * wave) * 6 * DM + j0 + lane;
                float a0 = 0.f, a1 = 0.f, a2 = 0.f, a3 = 0.f;
#pragma unroll 8
                for (int k = 0; k < 128; ++k) { const float w = wp[(size_t)k * 6 * DM]; const int kk = 128 * wave + k;
                    a0 += cs[kk] * w; a1 += cs[DM + kk] * w; a2 += cs[2 * DM + kk] * w; a3 += cs[3 * DM + kk] * w; }
                red[(wave * 4 + 0) * 64 + lane] = a0; red[(wave * 4 + 1) * 64 + lane] = a1; red[(wave * 4 + 2) * 64 + lane] = a2; red[(wave * 4 + 3) * 64 + lane] = a3;
                __syncthreads();
                if (tid < 256) { const int b = tid >> 6, j = tid & 63; float sacc = p.b_ada[l * 6 * DM + j0 + j];
                    for (int w = 0; w < 8; ++w) sacc += red[(w * 4 + b) * 64 + j];
                    mod[((size_t)l * NBATCH + b) * 6 * DM + j0 + j] = sacc; }
                __syncthreads();
            }
        }
        {
            LAS float* scr = (LAS float*)(lds + wave * 16384);
            constexpr int I_IN = 16 * (INC / 32), I_BS = 8 * 32, I_OUT = 16 * 32, I_UP = 16 * (UPN / 32), I_DN = (DFF / 64) * 32;
            constexpr int I_L = I_IN + 2 * I_BS + I_OUT + I_UP + I_DN;
            for (int it = gw; it < DEPTH * I_L; it += ngw) {
                const int l = it / I_L; int r = it % I_L;
                bf16_t* wl = (bf16_t*)(ws + WS_W + (size_t)l * W_LAYER);
                if (r < I_IN) { const int nblk = INC / 32, kb = r / nblk, nb = r % nblk;
                    transpose_item(p.w_in + (size_t)l * DM * INC, INC, 64 * kb, 32 * nb, (bf16_t*)((char*)wl + W_IN), DM, 32 * nb, 64 * kb, scr, lane); continue; } r -= I_IN;
                if (r < I_BS) { const int kb = r / 32, nb = r % 32;
                    transpose_item(p.w_bs + (size_t)l * 512 * DM, DM, 64 * kb, 32 * nb, (bf16_t*)((char*)wl + W_BR), DM, 32 * nb, 64 * kb, scr, lane); continue; } r -= I_BS;
                if (r < I_BS) { const int kb = r / 32, nb = r % 32;
                    transpose_item(p.w_bd + (size_t)l * 512 * DM, DM, 64 * kb, 32 * nb, (bf16_t*)((char*)wl + W_BR), DM, 32 * nb, 512 + 64 * kb, scr, lane); continue; } r -= I_BS;
                if (r < I_OUT) { const int kb = r / 32, nb = r % 32;
                    transpose_item(p.w_out + (size_t)l * DM * DM, DM, 64 * kb, 32 * nb, (bf16_t*)((char*)wl + W_OUT), DM, 32 * nb, 64 * kb, scr, lane); continue; } r -= I_OUT;
                if (r < I_UP) { const int nblk = UPN / 32, kb = r / nblk, nb = r % nblk; const int n0 = 32 * nb;
                    const int drow = (n0 < DFF) ? ((n0 / 128) * 256 + (n0 % 128)) : (((n0 - DFF) / 128) * 256 + 128 + ((n0 - DFF) % 128));
                    transpose_item(p.w_up + (size_t)l * DM * UPN, UPN, 64 * kb, n0, (bf16_t*)((char*)wl + W_UP), DM, drow, 64 * kb, scr, lane); continue; } r -= I_UP;
                { const int kb = r / 32, nb = r % 32;
                    transpose_item(p.w_down + (size_t)l * DFF * DM, DM, 64 * kb, 32 * nb, (bf16_t*)((char*)wl + W_DN), DFF, 32 * nb, 64 * kb, scr, lane); }
            }
        }
        __syncthreads();
    }
    SEAM(phase); ++phase;

    for (int l = 0; l < DEPTH; ++l) {
        const float* modl = mod + (size_t)l * NBATCH * 6 * DM;
        const unsigned char* wl = ws + WS_W + (size_t)l * W_LAYER;
        const float* xin = (l == 0) ? p.x : X;
        if (RUN(phase)) norm_phase(xin, Hb, p.norm1_g + l * DM, modl + 0 * DM, modl + 1 * DM, gw, ngw, lane);
        SEAM(phase); ++phase;
        if (RUN(phase)) {
            pg8::Gemm g{Hb, (const bf16_t*)(wl + W_IN), DM, DM, DM}; pg8::StaticOrder S; S.init(NTOK / 256, INC / 256, G, bid, 0);
            pg8::EpiInProj E{PROJ};
            pg8::gemm_phase<pg8::EpiInProj, pg8::StaticOrder>(lds, g, S, E);
        }
        SEAM(phase); ++phase;
        if (RUN(phase)) {
            for (int u = bid; u < 256; u += G) att::swa_unit(PROJ, Ob, u >> 6, (u >> 5) & 1, u & 31, p.sinks + l * 8, (LAS char*)lds);
            const float lam = lamv[l], post = 1.0f - (0.8f - 0.6f * expf(-0.3f * (float)l));
            for (int u = bid; u < 256; u += G) {
                const int bh = u >> 4, j = u & 15;
                att::diff_unit(PROJ, Ob, bh >> 2, bh & 3, j, lam, post, p.subg + l * 128, (LAS char*)lds);
                att::diff_unit(PROJ, Ob, bh >> 2, bh & 3, 31 - j, lam, post, p.subg + l * 128, (LAS char*)lds);
            }
        }
        SEAM(phase); ++phase;
        if (RUN(phase)) {
            pg8::Gemm g{Ob, (const bf16_t*)(wl + W_BR), DM, DM, 512}; pg8::StaticOrder S; S.init(NTOK / 256, DM / 256, G, bid, 2);
            pg8::EpiMerge E{PROJ, MGb};
            pg8::gemm_phase<pg8::EpiMerge, pg8::StaticOrder>(lds, g, S, E);
        }
        SEAM(phase); ++phase;
        if (RUN(phase)) {
            pg8::Gemm g{MGb, (const bf16_t*)(wl + W_OUT), DM, DM, DM}; pg8::StaticOrder S; S.init(NTOK / 256, DM / 256, G, bid, 0);
            pg8::EpiRes E{xin, X, modl + 2 * DM};
            pg8::gemm_phase<pg8::EpiRes, pg8::StaticOrder>(lds, g, S, E);
        }
        SEAM(phase); ++phase;
        if (RUN(phase)) norm_phase(X, Hb, p.norm2_g + l * DM, modl + 3 * DM, modl + 4 * DM, gw, ngw, lane);
        SEAM(phase); ++phase;
        if (RUN(phase)) {
            pg8::Gemm g{Hb, (const bf16_t*)(wl + W_UP), DM, DM, DM}; pg8::StaticOrder S; S.init(NBATCH * UP_MT, UPN / 256, G, bid, 1);
            pg8::EpiUp E{ACT, p.conv_w + (size_t)l * 3 * DFF, p.conv_b + (size_t)l * DFF, (LAS float*)(lds + HALO_OFF)};
            pg8::gemm_phase<pg8::EpiUp, pg8::StaticOrder>(lds, g, S, E);
        }
        SEAM(phase); ++phase;
        if (RUN(phase)) {
            pg8::Gemm g{ACT, (const bf16_t*)(wl + W_DN), DFF, DFF, DFF}; pg8::StaticOrder S; S.init(NTOK / 256, DM / 256, G, bid, 0);
            pg8::EpiRes E{X, X, modl + 5 * DM};
            pg8::gemm_phase<pg8::EpiRes, pg8::StaticOrder>(lds, g, S, E);
        }
        SEAM(phase); ++phase;
    }
    if (RUN(phase)) {
        for (int m = gw; m < NTOK; m += ngw) {
            float* xr = X + (size_t)m * DM;
            f32x4 v[4]; float ss = 0.f;
#pragma unroll
            for (int j = 0; j < 4; ++j) { v[j] = *(const f32x4*)(xr + 4 * lane + 256 * j); ss += (v[j].x * v[j].x + v[j].y * v[j].y) + (v[j].z * v[j].z + v[j].w * v[j].w); }
            const float rstd = rsqrtf(wave_sum(ss) * (1.0f / DM) + RMS_EPS);
#pragma unroll
            for (int j = 0; j < 4; ++j) { const f32x4 gg = *(const f32x4*)(p.final_g + 4 * lane + 256 * j); *(f32x4*)(xr + 4 * lane + 256 * j) = v[j] * rstd * gg; }
        }
    }
#undef RUN
#undef SEAM
}

constexpr int N_PHASES = 1 + DEPTH * 8 + 1;

extern "C" void kernel_launch(void* const* d_in, const int* in_sizes, int n_in, void* d_out, int out_size, void* d_ws, size_t ws_size, hipStream_t stream) {
    static int grid = 0;
    if (grid == 0) {
        if (n_in != 18 || in_sizes[0] != NTOK * DM || out_size != NTOK * DM || ws_size < WS_END) {
            fprintf(stderr, "kernel_launch: unexpected shapes (n_in %d, in0 %d, out %d, ws %zu); nothing launched\n", n_in, n_in > 0 ? in_sizes[0] : -1, out_size, ws_size); grid = -1; return; }
        int dev = 0, cus = 0, per_cu = 0;
        if (hipGetDevice(&dev) != hipSuccess || hipDeviceGetAttribute(&cus, hipDeviceAttributeMultiprocessorCount, dev) != hipSuccess) { grid = -1; return; }
        if (hipFuncSetAttribute((const void*)fwd_mega, hipFuncAttributeMaxDynamicSharedMemorySize, LDS_BYTES) != hipSuccess) { fprintf(stderr, "kernel_launch: hipFuncSetAttribute failed\n"); grid = -1; return; }
        if (hipOccupancyMaxActiveBlocksPerMultiprocessor(&per_cu, (const void*)fwd_mega, 512, LDS_BYTES) != hipSuccess || per_cu < 1) { fprintf(stderr, "kernel_launch: occupancy query gave %d\n", per_cu); per_cu = 1; }
        (void)hipGetLastError();
        grid = cus * 1;
    }
    if (grid < 0) return;
    Params p{};
    const float** pp = (const float**)&p;
    for (int i = 0; i < 18; ++i) pp[i] = (const float*)d_in[i];
    p.out = (float*)d_out; p.ws = (unsigned char*)d_ws; p.ph_lo = 0; p.ph_hi = N_PHASES;
    void* args[] = {&p};
    hipError_t e = hipLaunchCooperativeKernel((const void*)fwd_mega, dim3(grid), dim3(512), args, LDS_BYTES, stream);
    if (e != hipSuccess) fprintf(stderr, "cooperative launch failed: %s (grid %d)\n", hipGetErrorString(e), grid);
}
```

```cpp
#include <hip/hip_runtime.h>
#include <hip/hip_cooperative_groups.h>
#include <cstdio>
#include <cstdint>
#include <cstddef>
namespace cg = cooperative_groups;

#define LAS __attribute__((address_space(3)))
typedef unsigned short bf16_t;
typedef short bf16x8 __attribute__((ext_vector_type(8)));
typedef float f32x4 __attribute__((ext_vector_type(4)));
typedef float f32x2 __attribute__((ext_vector_type(2)));
typedef float f32x16 __attribute__((ext_vector_type(16)));
typedef unsigned u32x4 __attribute__((ext_vector_type(4)));
typedef unsigned u32x2 __attribute__((ext_vector_type(2)));

constexpr int DM = 1024, NBATCH = 4, SEQ = 4096, NTOK = NBATCH * SEQ, DEPTH = 4;
constexpr int INC = 4352, DFF = 2816, UPN = 2 * DFF;
constexpr int C_QA = 0, C_KA = 512, C_VA = 640, C_QD = 768, C_KD = 1280, C_VD = 1792, C_GA = 2304, C_GD = 3328;
constexpr float LOG2E = 1.4426950408889634f;
constexpr float QSCALE = 0.125f * LOG2E;
constexpr float RMS_EPS = 1e-6f;
constexpr int UP_MT = 17;

constexpr size_t MiB = 1u << 20;
constexpr size_t WS_LAM = 0;
constexpr size_t WS_MOD = 64 * 1024;
constexpr size_t WS_BAR = 512 * 1024;
constexpr size_t WS_W = 2 * MiB;
constexpr size_t W_IN = 0, W_BR = (size_t)INC * DM * 2, W_OUT = W_BR + (size_t)DM * DM * 2, W_UP = W_OUT + (size_t)DM * DM * 2,
                 W_DN = W_UP + (size_t)UPN * DM * 2, W_LAYER = W_DN + (size_t)DM * DFF * 2;
static_assert(W_LAYER == 29 * MiB, "weights per layer");
constexpr size_t WS_H = 120 * MiB;
constexpr size_t WS_O = 152 * MiB;
constexpr size_t WS_MG = 184 * MiB;
constexpr size_t WS_PROJ = 216 * MiB;
constexpr size_t WS_ACT = WS_PROJ;
constexpr size_t WS_END = 352 * MiB;
static_assert(WS_PROJ + (size_t)NTOK * INC * 2 <= WS_END, "ws map");

constexpr int RING_BYTES = 131072;
constexpr int HALO_OFF = RING_BYTES;
constexpr int MISC_OFF = RING_BYTES + 4096;
constexpr int LDS_BYTES = RING_BYTES + 8192;

__device__ __forceinline__ unsigned cvt_pk_bf16(float lo, float hi) { unsigned r; asm volatile("v_cvt_pk_bf16_f32 %0, %1, %2" : "=v"(r) : "v"(lo), "v"(hi)); return r; }
__device__ __forceinline__ float bf_lo(unsigned w) { return __builtin_bit_cast(float, w << 16); }
__device__ __forceinline__ float bf_hi(unsigned w) { return __builtin_bit_cast(float, w & 0xffff0000u); }
__device__ __forceinline__ float fast_exp2(float x) { return __builtin_amdgcn_exp2f(x); }
__device__ __forceinline__ float fast_rcp(float x) { return __builtin_amdgcn_rcpf(x); }
__device__ __forceinline__ float sigmoidf_(float x) { return fast_rcp(1.0f + fast_exp2(-x * LOG2E)); }

namespace pg8 {
constexpr int BM = 256, BK = 64, HALF = 128, HTB = HALF * BK * 2, STAGE_BYTES = 8 * HTB, NXCD = 8, WGM = 8;
__host__ __device__ __forceinline__ int lds_byte(int r, int c) { const int st = (r >> 4) * 2 + (c >> 5), rr = r & 15, cc = c & 31, ob = rr * 64 + cc * 2; return st * 1024 + (ob ^ (((ob >> 9) & 1) << 5)); }
__host__ __device__ __forceinline__ void stage_rc(int b, int& R, int& C) { const int st = b / 1024, sb = b % 1024, swz = sb ^ (((sb >> 9) & 1) << 5); R = (st >> 1) * 16 + swz / 64; C = (st & 1) * 32 + (swz % 64) / 2; }
__host__ __device__ __forceinline__ int perm32(int rho) { const int n = rho >> 4, i = rho & 15; return 8 * (i >> 2) + 4 * n + (i & 3); }

struct Unit { int pm, pn, arow, koff, half; };
struct Gemm { const bf16_t* A; const bf16_t* Bt; int lda, ldb, K; };

struct StaticOrder {
    int nM, nN, nwg, G, c, mode;
    __device__ void init(int nM_, int nN_, int G_, int c_, int mode_) { nM = nM_; nN = nN_; nwg = nM * nN; G = G_; c = c_; mode = mode_; }
    __device__ bool next(int i, Unit& u) const {
        const int ti = (mode == 2) ? (i >> 1) : i;
        const long L = (long)ti * G + c; if (L >= nwg) return false;
        int wgid = (int)L; { const int q = nwg / NXCD, r = nwg % NXCD, xcd = wgid % NXCD, off = wgid / NXCD; wgid = (xcd < r ? xcd * (q + 1) : r * (q + 1) + (xcd - r) * q) + off; }
        const int nig = WGM * nN, gid = wgid / nig, fm = gid * WGM, gsz = (nM - fm) < WGM ? (nM - fm) : WGM;
        u.pm = fm + ((wgid % nig) % gsz); u.pn = (wgid % nig) / gsz;
        u.arow = (mode != 1) ? u.pm * BM : (u.pm / UP_MT) * SEQ + 254 * (u.pm % UP_MT) - 2;
        u.half = (mode == 2) ? (i & 1) : 1; u.koff = (mode == 2) ? (i & 1) * 512 : 0;
        return true;
    }
};

template <class Epi, class Sched, bool ALIGN_EPI = true, bool SP2 = true>
__device__ __forceinline__ void gemm_phase(LAS unsigned char* lds, const Gemm g, const Sched& S, const Epi& E) {
    int tid_ = threadIdx.x; asm volatile("" : "+v"(tid_));
    const int tid = tid_, wid = __builtin_amdgcn_readfirstlane(tid >> 6), lane = tid & 63, wr = wid >> 2, wc = wid & 3, fr = lane & 15, fq = lane >> 4;
    const int K = g.K, nt = K / BK;
    unsigned voffA[2], voffB[2];
#pragma unroll
    for (int i = 0; i < 2; ++i) { int R, C; stage_rc(tid * 16 + i * 8192, R, C); const int Rb = Epi::PERM ? ((R & ~31) + perm32(R & 31)) : R;
        voffA[i] = (unsigned)(R * g.lda + C) * 2u; voffB[i] = (unsigned)(Rb * g.ldb + C) * 2u; }
    const size_t kstep = (size_t)(BK * 2);
    const size_t hstepA = (size_t)HALF * g.lda * 2, hstepB = (size_t)HALF * g.ldb * 2;
    const unsigned ldsw = (unsigned)wid * 1024u;
    const int aoff = lds_byte(wr * 64 + fr, fq * 8), boff = lds_byte(wc * 32 + fr, fq * 8);
#define PG8_SA(b, h) (((b) * 2 + (h)) * HTB)
#define PG8_SB(b, h) ((4 + (b) * 2 + (h)) * HTB)
#define PG8_STAGE(bufoff, gbase, voff) do { _Pragma("unroll") for (int _i = 0; _i < 2; ++_i) \
        __builtin_amdgcn_global_load_lds((const unsigned*)((const char*)(gbase) + (voff)[_i]), (LAS unsigned*)(lds + (bufoff) + ldsw + _i * 8192), 16, 0, 0); } while (0)
#define PG8_LDA(dst, b, h) do { _Pragma("unroll") for (int m = 0; m < 4; ++m) _Pragma("unroll") for (int k = 0; k < 2; ++k) dst[m][k] = *(const LAS bf16x8*)(lds + PG8_SA(b, h) + aoff + m * 2048 + k * 1024); } while (0)
#define PG8_LDB(dst, b, h) do { _Pragma("unroll") for (int n = 0; n < 2; ++n) _Pragma("unroll") for (int k = 0; k < 2; ++k) dst[n][k] = *(const LAS bf16x8*)(lds + PG8_SB(b, h) + boff + n * 2048 + k * 1024); } while (0)
#define PG8_MMA(ai, bj, At, Bt) do { __builtin_amdgcn_s_setprio(1); _Pragma("unroll") for (int m = 0; m < 4; ++m) _Pragma("unroll") for (int n = 0; n < 2; ++n) _Pragma("unroll") for (int k = 0; k < 2; ++k) \
        acc[ai][bj][m][n] = __builtin_amdgcn_mfma_f32_16x16x32_bf16(Bt[n][k], At[m][k], acc[ai][bj][m][n], 0, 0, 0); __builtin_amdgcn_s_setprio(0); } while (0)
#define PG8_WAIT_V(n) asm volatile("s_waitcnt vmcnt(" #n ")" ::: "memory")
#define PG8_WAIT_L(n) asm volatile("s_waitcnt lgkmcnt(" #n ")" ::: "memory")
#define PG8_BAR __builtin_amdgcn_s_barrier()
#define PG8_SCHED __builtin_amdgcn_sched_barrier(0)
    Unit cur, nxt; int ui = 0;
    if (!S.next(0, cur)) return;
    f32x4 acc[2][2][4][2];
#pragma unroll
    for (int a = 0; a < 2; ++a)
#pragma unroll
        for (int b = 0; b < 2; ++b)
#pragma unroll
            for (int m = 0; m < 4; ++m)
#pragma unroll
                for (int n = 0; n < 2; ++n) acc[a][b][m][n] = (f32x4){0.f, 0.f, 0.f, 0.f};
    bf16x8 At[4][2], B0[2][2], B1[2][2];
    const char* cA = (const char*)g.A + (ptrdiff_t)cur.arow * g.lda * 2 + cur.koff * 2; const char* cB = (const char*)g.Bt + (size_t)cur.pn * 2 * hstepB + cur.koff * 2;
    {
        PG8_STAGE(PG8_SB(0, 0), cB, voffB); PG8_STAGE(PG8_SB(0, 1), cB + hstepB, voffB); PG8_STAGE(PG8_SA(0, 0), cA, voffA); PG8_STAGE(PG8_SA(0, 1), cA + hstepA, voffA);
        if (wr == 1) PG8_BAR;
        PG8_WAIT_V(2); PG8_BAR;
        PG8_STAGE(PG8_SB(1, 0), cB + kstep, voffB); PG8_STAGE(PG8_SA(1, 0), cA + kstep, voffA); PG8_STAGE(PG8_SB(1, 1), cB + hstepB + kstep, voffB);
        PG8_WAIT_V(6); PG8_BAR;
    }
    for (;;) {
        const bool has_next = S.next(ui + 1, nxt);
        const char* nA = has_next ? (const char*)g.A + (ptrdiff_t)nxt.arow * g.lda * 2 + nxt.koff * 2 : cA; const char* nB = has_next ? (const char*)g.Bt + (size_t)nxt.pn * 2 * hstepB + nxt.koff * 2 : cB;
        for (int t = 0; t < nt; t += 2) {
            const bool last = (t == nt - 2);
            const char* a1 = cA + (size_t)(t + 1) * kstep;
            const char* a2 = last ? nA : cA + (size_t)(t + 2) * kstep; const char* b2 = last ? nB : cB + (size_t)(t + 2) * kstep;
            const char* a3 = a2 + kstep; const char* b3 = b2 + kstep;
            PG8_LDB(B0, 0, 0); PG8_LDB(B1, 0, 1); PG8_SCHED; PG8_LDA(At, 0, 0); PG8_STAGE(PG8_SA(1, 1), a1 + hstepA, voffA);
            PG8_WAIT_V(8); PG8_WAIT_L(0); PG8_BAR; PG8_MMA(0, 0, At, B0); PG8_MMA(0, 1, At, B1); PG8_BAR; PG8_SCHED;
            PG8_LDA(At, 0, 1); PG8_STAGE(PG8_SB(0, 0), b2, voffB); PG8_STAGE(PG8_SB(0, 1), b2 + hstepB, voffB); PG8_STAGE(PG8_SA(0, 0), a2, voffA);
            PG8_WAIT_V(8); PG8_WAIT_L(0); PG8_BAR; PG8_MMA(1, 0, At, B0); PG8_MMA(1, 1, At, B1); PG8_BAR; PG8_SCHED;
            PG8_LDB(B0, 1, 0); PG8_LDB(B1, 1, 1); PG8_SCHED; PG8_LDA(At, 1, 0); PG8_STAGE(PG8_SA(0, 1), a2 + hstepA, voffA);
            PG8_WAIT_V(8); PG8_WAIT_L(0); PG8_BAR; PG8_MMA(0, 0, At, B0); PG8_MMA(0, 1, At, B1); PG8_BAR; PG8_SCHED;
            PG8_LDA(At, 1, 1); PG8_STAGE(PG8_SB(1, 0), b3, voffB); PG8_STAGE(PG8_SB(1, 1), b3 + hstepB, voffB); PG8_STAGE(PG8_SA(1, 0), a3, voffA);
            PG8_WAIT_V(8); PG8_WAIT_L(0); PG8_BAR; PG8_MMA(1, 0, At, B0); PG8_MMA(1, 1, At, B1); PG8_BAR; PG8_SCHED;
        }
        if constexpr (ALIGN_EPI) { if (wr == 0) PG8_BAR; }
        if constexpr (Epi::HAS_MID) { if (cur.half == 0) E.mid(acc, cur, wr, wc, fr, fq); else E(acc, cur, wr, wc, fr, fq); }
        else E(acc, cur, wr, wc, fr, fq);
        if (!has_next) break;
        if (!(Epi::HAS_MID && cur.half == 0)) {
#pragma unroll
        for (int a = 0; a < 2; ++a)
#pragma unroll
            for (int b = 0; b < 2; ++b)
#pragma unroll
                for (int m = 0; m < 4; ++m)
#pragma unroll
                    for (int n = 0; n < 2; ++n) acc[a][b][m][n] = (f32x4){0.f, 0.f, 0.f, 0.f};
        }
        cur = nxt; cA = nA; cB = nB; ++ui;
        if constexpr (ALIGN_EPI) { if (wr == 1) PG8_BAR; }
    }
    PG8_WAIT_V(0);
    if constexpr (!ALIGN_EPI) { if (wr == 0) PG8_BAR; }
    PG8_BAR;
#undef PG8_SA
#undef PG8_SB
#undef PG8_STAGE
#undef PG8_LDA
#undef PG8_LDB
#undef PG8_MMA
#undef PG8_WAIT_V
#undef PG8_WAIT_L
#undef PG8_BAR
#undef PG8_SCHED
}

__device__ __forceinline__ f32x2 gelu_pk(f32x2 v) {
    const f32x2 av = __builtin_elementwise_abs(v), d = av * 0.2316418882f + 1.0f;
    f32x2 t; t.x = __builtin_amdgcn_rcpf(d.x); t.y = __builtin_amdgcn_rcpf(d.y);
    f32x2 q = t * 0.5307027145f + (-0.7265760135f); q = q * t + 0.7107068705f; q = q * t + (-0.142248368f); q = q * t + 0.127414796f; q = q * t;
    const f32x2 s = (v * v) * (-0.72134752044f);
    f32x2 e; e.x = __builtin_amdgcn_exp2f(s.x); e.y = __builtin_amdgcn_exp2f(s.y);
    const f32x2 m = v * (q * e), r = v - m;
    f32x2 o; o.x = v.x < 0.f ? m.x : r.x; o.y = v.y < 0.f ? m.y : r.y; return o;
}


struct EpiInProj {
    static constexpr bool PERM = true, HAS_MID = false;
    bf16_t* O;
    __device__ __forceinline__ void operator()(const f32x4 (&acc)[2][2][4][2], const Unit& u, int wr, int wc, int fr, int fq) const {
        const int row0 = u.pm * BM + wr * 64 + fr;
#pragma unroll
        for (int bj = 0; bj < 2; ++bj) {
            const int colg = u.pn * BM + bj * HALF;
            const int kind = (colg < C_KA || (colg >= C_QD && colg < C_KD)) ? 1 : (colg >= C_GA ? 2 : 0);
            bf16_t* base = O + colg + wc * 32 + 8 * fq;
#pragma unroll
            for (int ai = 0; ai < 2; ++ai)
#pragma unroll
                for (int m = 0; m < 4; ++m) {
                    f32x4 v0 = acc[ai][bj][m][0], v1 = acc[ai][bj][m][1];
                    if (kind == 1) { v0 = v0 * QSCALE; v1 = v1 * QSCALE; }
                    else if (kind == 2) {
#pragma unroll
                        for (int j = 0; j < 4; ++j) { v0[j] = sigmoidf_(v0[j]); v1[j] = sigmoidf_(v1[j]); }
                    }
                    u32x4 w; w.x = cvt_pk_bf16(v0[0], v0[1]); w.y = cvt_pk_bf16(v0[2], v0[3]); w.z = cvt_pk_bf16(v1[0], v1[1]); w.w = cvt_pk_bf16(v1[2], v1[3]);
                    *(u32x4*)(base + (size_t)(row0 + ai * HALF + m * 16) * INC) = w;
                }
        }
    }
};

struct EpiMerge {
    static constexpr bool PERM = true, HAS_MID = true;
    const bf16_t* P; bf16_t* O;
    __device__ __forceinline__ void mid(f32x4 (&acc)[2][2][4][2], const Unit& u, int wr, int wc, int fr, int fq) const {
        const int row0 = u.pm * BM + wr * 64 + fr;
#pragma unroll
        for (int ai = 0; ai < 2; ++ai)
#pragma unroll
            for (int m = 0; m < 4; ++m) {
                const bf16_t* rp = P + (size_t)(row0 + ai * HALF + m * 16) * INC + u.pn * BM + wc * 32 + 8 * fq;
#pragma unroll
                for (int bj = 0; bj < 2; ++bj) {
                    const u32x4 ga = *(const u32x4*)(rp + C_GA + bj * HALF), gd = *(const u32x4*)(rp + C_GD + bj * HALF);
                    f32x4 r0, r1;
                    r0[0] = bf_lo(ga.x) * fast_rcp(bf_lo(gd.x)); r0[1] = bf_hi(ga.x) * fast_rcp(bf_hi(gd.x)); r0[2] = bf_lo(ga.y) * fast_rcp(bf_lo(gd.y)); r0[3] = bf_hi(ga.y) * fast_rcp(bf_hi(gd.y));
                    r1[0] = bf_lo(ga.z) * fast_rcp(bf_lo(gd.z)); r1[1] = bf_hi(ga.z) * fast_rcp(bf_hi(gd.z)); r1[2] = bf_lo(ga.w) * fast_rcp(bf_lo(gd.w)); r1[3] = bf_hi(ga.w) * fast_rcp(bf_hi(gd.w));
                    acc[ai][bj][m][0] = acc[ai][bj][m][0] * r0; acc[ai][bj][m][1] = acc[ai][bj][m][1] * r1;
                }
                asm volatile("" : "+v"(acc[ai][0][m][0]), "+v"(acc[ai][0][m][1]), "+v"(acc[ai][1][m][0]), "+v"(acc[ai][1][m][1]) :: "memory");
            }
    }
    __device__ __forceinline__ void operator()(const f32x4 (&acc)[2][2][4][2], const Unit& u, int wr, int wc, int fr, int fq) const {
        const int row0 = u.pm * BM + wr * 64 + fr;
#pragma unroll
        for (int ai = 0; ai < 2; ++ai)
#pragma unroll
            for (int m = 0; m < 4; ++m) {
                const size_t row = (size_t)(row0 + ai * HALF + m * 16);
                const int col = u.pn * BM + wc * 32 + 8 * fq;
#pragma unroll
                for (int bj = 0; bj < 2; ++bj) {
                    const u32x4 gd = *(const u32x4*)(P + row * INC + C_GD + col + bj * HALF);
                    const f32x4 v0 = acc[ai][bj][m][0], v1 = acc[ai][bj][m][1];
                    u32x4 w; w.x = cvt_pk_bf16(v0[0] * bf_lo(gd.x), v0[1] * bf_hi(gd.x)); w.y = cvt_pk_bf16(v0[2] * bf_lo(gd.y), v0[3] * bf_hi(gd.y));
                    w.z = cvt_pk_bf16(v1[0] * bf_lo(gd.z), v1[1] * bf_hi(gd.z)); w.w = cvt_pk_bf16(v1[2] * bf_lo(gd.w), v1[3] * bf_hi(gd.w));
                    *(u32x4*)(O + row * DM + col + bj * HALF) = w;
                }
            }
    }
};

struct EpiRes {
    static constexpr bool PERM = false, HAS_MID = false;
    const float* in; float* out; const float* gate;
    __device__ __forceinline__ void operator()(const f32x4 (&acc)[2][2][4][2], const Unit& u, int wr, int wc, int fr, int fq) const {
        const int col0 = u.pn * BM + wc * 32 + 4 * fq; const int b = (u.pm * BM) / SEQ;
        f32x4 gv[2][2];
#pragma unroll
        for (int bj = 0; bj < 2; ++bj)
#pragma unroll
            for (int n = 0; n < 2; ++n) gv[bj][n] = *(const f32x4*)(gate + (size_t)b * 6 * DM + col0 + bj * HALF + n * 16);
#pragma unroll
        for (int ai = 0; ai < 2; ++ai)
#pragma unroll
            for (int m = 0; m < 4; ++m) { const size_t off = (size_t)(u.pm * BM + ai * HALF + wr * 64 + m * 16 + fr) * DM + col0;
#pragma unroll
                for (int bj = 0; bj < 2; ++bj)
#pragma unroll
                    for (int n = 0; n < 2; ++n) { const f32x4 bs = *(const f32x4*)(in + off + bj * HALF + n * 16);
                        *(f32x4*)(out + off + bj * HALF + n * 16) = bs + gv[bj][n] * acc[ai][bj][m][n]; }
            }
    }
};

__device__ __forceinline__ float dpp_ror1(float v) { return __builtin_bit_cast(float, __builtin_amdgcn_update_dpp(0, __builtin_bit_cast(int, v), 0x121, 0xf, 0xf, false)); }
__device__ __forceinline__ float dpp_ror2(float v) { return __builtin_bit_cast(float, __builtin_amdgcn_update_dpp(0, __builtin_bit_cast(int, v), 0x122, 0xf, 0xf, false)); }

struct EpiUp {
    static constexpr bool PERM = true, HAS_MID = false;
    bf16_t* ACT; const float* cw; const float* cb; LAS float* halo;
    __device__ __forceinline__ void operator()(f32x4 (&acc)[2][2][4][2], const Unit& u, int wr, int wc, int fr, int fq) const {
        const int b = u.pm / UP_MT, i = u.pm % UP_MT, pos0 = 254 * i - 2;
        const int lc = wc * 32 + 8 * fq;
        const int cbase = u.pn * HALF + lc;
        if (i == 0 && wr == 0 && fr < 2) { acc[0][0][0][0] = (f32x4){0.f, 0.f, 0.f, 0.f}; acc[0][0][0][1] = (f32x4){0.f, 0.f, 0.f, 0.f}; }
        if (fr >= 14) {
#pragma unroll
            for (int ai = 0; ai < 2; ++ai)
#pragma unroll
                for (int n = 0; n < 2; ++n) *(LAS f32x4*)(halo + ((ai * 2 + wr) * 2 + (fr - 14)) * HALF + lc + 4 * n) = acc[ai][0][3][n];
        }
        asm volatile("s_waitcnt lgkmcnt(0)" ::: "memory"); __builtin_amdgcn_s_barrier(); asm volatile("" ::: "memory");
#pragma unroll
        for (int n = 0; n < 2; ++n) {
            const f32x4 w0 = *(const f32x4*)(cw + cbase + 4 * n), w1 = *(const f32x4*)(cw + DFF + cbase + 4 * n),
                        w2 = *(const f32x4*)(cw + 2 * DFF + cbase + 4 * n), bv = *(const f32x4*)(cb + cbase + 4 * n);
#pragma unroll
            for (int ai = 0; ai < 2; ++ai)
#pragma unroll
                for (int m = 0; m < 4; ++m) {
                    const f32x4 cur = acc[ai][0][m][n];
                    f32x4 p1, p2;
                    if (m > 0) {
                        const f32x4 pr = acc[ai][0][m - 1][n];
#pragma unroll
                        for (int j = 0; j < 4; ++j) { const float r1 = dpp_ror1(cur[j]), r2 = dpp_ror2(cur[j]), q1 = dpp_ror1(pr[j]), q2 = dpp_ror2(pr[j]);
                            p1[j] = fr >= 1 ? r1 : q1; p2[j] = fr >= 2 ? r2 : q2; }
                    } else {
                        f32x4 h0 = (f32x4){0.f, 0.f, 0.f, 0.f}, h1 = h0;
                        if (!(ai == 0 && wr == 0)) { const int sidx = (wr == 1) ? (ai * 2) : ((ai - 1) * 2 + 1);
                            h0 = *(const LAS f32x4*)(halo + (sidx * 2 + 0) * HALF + lc + 4 * n); h1 = *(const LAS f32x4*)(halo + (sidx * 2 + 1) * HALF + lc + 4 * n); }
#pragma unroll
                        for (int j = 0; j < 4; ++j) { const float r1 = dpp_ror1(cur[j]), r2 = dpp_ror2(cur[j]);
                            p1[j] = fr >= 1 ? r1 : h1[j]; p2[j] = fr >= 2 ? r2 : (fr == 1 ? h1[j] : h0[j]); }
                    }
                    const f32x4 a = p2 * w0 + p1 * w1 + cur * w2 + bv;
                    const f32x2 g0 = gelu_pk((f32x2){a[0], a[1]}), g1 = gelu_pk((f32x2){a[2], a[3]});
                    const f32x4 gg = acc[ai][1][m][n];
                    const int tr = ai * HALF + wr * 64 + m * 16 + fr, p = pos0 + tr;
                    if (tr >= 2 && p < SEQ) {
                        u32x2 w; w.x = cvt_pk_bf16(g0.x * gg[0], g0.y * gg[1]); w.y = cvt_pk_bf16(g1.x * gg[2], g1.y * gg[3]);
                        *(u32x2*)(ACT + (size_t)(b * SEQ + p) * DFF + cbase + 4 * n) = w;
                    }
                }
        }
    }
};
}

namespace att {
typedef short v4i16 __attribute__((ext_vector_type(4)));
__device__ __forceinline__ f32x16 mfma32(bf16x8 a, bf16x8 b, f32x16 c) { return __builtin_amdgcn_mfma_f32_32x32x16_bf16(a, b, c, 0, 0, 0); }
__device__ __forceinline__ v4i16 vtr(const LAS char* p) { return __builtin_amdgcn_ds_read_tr16_b64_v4i16((LAS v4i16*)p); }
__device__ __forceinline__ int klocal(int r, int hi) { return 8 * (r >> 2) + 4 * hi + (r & 3); }

template <int NDB> struct St { f32x16 O[NDB]; float M, l; };

template <int NDB>
__device__ __forceinline__ void step(St<NDB>& s, const bf16x8 (&qf)[4], const f32x16& cval, float c32, float T,
                                     const LAS char* Kl, int KP, const LAS char* Vl, int VP, int krow, int nb, int mask0, int mask1, int lane) {
    const int l32 = lane & 31, hi = lane >> 5;
    const float NEG = -__builtin_inff();
    f32x16 x0 = cval, x1;
    const LAS char* kp = Kl + (krow + l32) * KP + hi * 16;
#pragma unroll
    for (int ks = 0; ks < 4; ++ks) x0 = mfma32(*(const LAS bf16x8*)(kp + ks * 32), qf[ks], x0);
    if (nb == 2) {
        x1 = cval;
#pragma unroll
        for (int ks = 0; ks < 4; ++ks) x1 = mfma32(*(const LAS bf16x8*)(kp + 32 * KP + ks * 32), qf[ks], x1);
#pragma unroll
        for (int r = 0; r < 16; ++r) x1[r] += c32;
    } else {
#pragma unroll
        for (int r = 0; r < 16; ++r) x1[r] = NEG;
    }
    if (mask0 == 1) {
#pragma unroll
        for (int r = 0; r < 16; ++r) if (klocal(r, hi) > l32) x0[r] = NEG;
    } else if (mask0 == 2) {
#pragma unroll
        for (int r = 0; r < 16; ++r) if (klocal(r, hi) <= l32) x0[r] = NEG;
    }
    if (mask1 == 1) {
#pragma unroll
        for (int r = 0; r < 16; ++r) if (klocal(r, hi) > l32) x1[r] = NEG;
    }
    float mx = x0[0];
#pragma unroll
    for (int r = 1; r < 16; ++r) mx = fmaxf(mx, x0[r]);
#pragma unroll
    for (int r = 0; r < 16; ++r) mx = fmaxf(mx, x1[r]);
    mx = fmaxf(mx, __shfl_xor(mx, 32));
    const float Mn = fmaxf(s.M, mx + T), alpha = fast_exp2(s.M - Mn), mrel = Mn - T;
    s.M = Mn;
    float sum = 0.f;
#pragma unroll
    for (int r = 0; r < 16; ++r) { x0[r] = fast_exp2(x0[r] - mrel); sum += x0[r]; }
#pragma unroll
    for (int r = 0; r < 16; ++r) { x1[r] = fast_exp2(x1[r] - mrel); sum += x1[r]; }
    s.l = s.l * alpha + sum;
#pragma unroll
    for (int db = 0; db < NDB; ++db) s.O[db] = s.O[db] * alpha;
    const int qd = (lane & 15) >> 2, blk = (lane >> 4) & 1, pp = lane & 3;
    const LAS char* vp = Vl + (krow + 4 * hi + qd) * VP + (16 * blk + 4 * pp) * 2;
#pragma unroll
    for (int kb = 0; kb < 2; ++kb) {
        if (kb == 1 && nb != 2) break;
#pragma unroll
        for (int ks2 = 0; ks2 < 2; ++ks2) {
            u32x4 pw;
            if (kb == 0) { pw.x = cvt_pk_bf16(x0[8 * ks2 + 0], x0[8 * ks2 + 1]); pw.y = cvt_pk_bf16(x0[8 * ks2 + 2], x0[8 * ks2 + 3]); pw.z = cvt_pk_bf16(x0[8 * ks2 + 4], x0[8 * ks2 + 5]); pw.w = cvt_pk_bf16(x0[8 * ks2 + 6], x0[8 * ks2 + 7]); }
            else         { pw.x = cvt_pk_bf16(x1[8 * ks2 + 0], x1[8 * ks2 + 1]); pw.y = cvt_pk_bf16(x1[8 * ks2 + 2], x1[8 * ks2 + 3]); pw.z = cvt_pk_bf16(x1[8 * ks2 + 4], x1[8 * ks2 + 5]); pw.w = cvt_pk_bf16(x1[8 * ks2 + 6], x1[8 * ks2 + 7]); }
            const bf16x8 pf = __builtin_bit_cast(bf16x8, pw);
            const LAS char* vr = vp + (32 * kb + 16 * ks2) * VP;
#pragma unroll
            for (int db = 0; db < NDB; ++db) {
                const v4i16 lo = vtr(vr + db * 64), hh = vtr(vr + 8 * VP + db * 64);
                const bf16x8 vf = (bf16x8){lo[0], lo[1], lo[2], lo[3], hh[0], hh[1], hh[2], hh[3]};
                s.O[db] = mfma32(vf, pf, s.O[db]);
            }
            __builtin_amdgcn_sched_barrier(0);
        }
    }
}

constexpr int DKP = 272, DVP = 320, DKB = 64 * DKP, DVB = 64 * DVP, DV0 = 2 * DKB;
__device__ __forceinline__ void diff_unit(const bf16_t* PROJ, bf16_t* OUT, int b, int h, int qblk, float lam, float post, const float* subg, LAS char* lds) {
    int tid_ = threadIdx.x; asm volatile("" : "+v"(tid_));
    const int tid = tid_, lane = tid & 63, wave = __builtin_amdgcn_readfirstlane(tid >> 6), l32 = lane & 31, hi = lane >> 5;
    const int map = wave >> 2, qs = wave & 3, q0 = qblk * 128, qw0 = q0 + 32 * qs;
    const float slope2 = exp2f(-2.0f * (float)(h + 1)) * LOG2E, c32 = 32.f * slope2;
    f32x16 cval;
#pragma unroll
    for (int r = 0; r < 16; ++r) cval[r] = slope2 * (float)klocal(r, hi);
    bf16x8 qf[4];
    { const bf16_t* qp = PROJ + (size_t)(b * SEQ + qw0 + l32) * INC + C_QD + h * 128 + map * 64 + hi * 8;
#pragma unroll
      for (int ks = 0; ks < 4; ++ks) qf[ks] = *(const bf16x8*)(qp + ks * 16); }
    St<4> s;
#pragma unroll
    for (int db = 0; db < 4; ++db)
#pragma unroll
        for (int r = 0; r < 16; ++r) s.O[db][r] = 0.f;
    s.M = -1e30f; s.l = 0.f;
    const int ntiles = 2 * qblk + 2;
    const int lrow = tid >> 4, lch = tid & 15;
    const bf16_t* kg = PROJ + (size_t)(b * SEQ + lrow) * INC + C_KD + h * 128 + lch * 8;
    const bf16_t* vg = PROJ + (size_t)(b * SEQ + lrow) * INC + C_VD + h * 128 + lch * 8;
    u32x4 kr[2], vr[2];
#pragma unroll
    for (int i = 0; i < 2; ++i) { kr[i] = *(const u32x4*)(kg + (size_t)(32 * i) * INC); vr[i] = *(const u32x4*)(vg + (size_t)(32 * i) * INC); }
#pragma unroll
    for (int i = 0; i < 2; ++i) { *(LAS u32x4*)(lds + (lrow + 32 * i) * DKP + lch * 16) = kr[i]; *(LAS u32x4*)(lds + DV0 + (lrow + 32 * i) * DVP + lch * 16) = vr[i]; }
    __syncthreads();
    for (int kt = 0; kt < ntiles; ++kt) {
        const int cb = kt & 1, nbuf = cb ^ 1;
        const bool more = (kt + 1 < ntiles);
        if (more) {
#pragma unroll
            for (int i = 0; i < 2; ++i) { kr[i] = *(const u32x4*)(kg + (size_t)(64 * (kt + 1) + 32 * i) * INC); vr[i] = *(const u32x4*)(vg + (size_t)(64 * (kt + 1) + 32 * i) * INC); }
        }
        const int k0 = 64 * kt;
        const int nb = (k0 > qw0) ? 0 : ((k0 + 32 > qw0) ? 1 : 2);
        if (nb > 0) {
            const int m0 = (k0 == qw0) ? 1 : 0, m1 = (k0 + 32 == qw0) ? 1 : 0;
            step<4>(s, qf, cval, c32, slope2 * (float)(k0 - qw0), lds + cb * DKB + map * 128, DKP, lds + DV0 + cb * DVB, DVP, 0, nb, m0, m1, lane);
        }
        if (more) {
#pragma unroll
            for (int i = 0; i < 2; ++i) { *(LAS u32x4*)(lds + nbuf * DKB + (lrow + 32 * i) * DKP + lch * 16) = kr[i]; *(LAS u32x4*)(lds + DV0 + nbuf * DVB + (lrow + 32 * i) * DVP + lch * 16) = vr[i]; }
        }
        __syncthreads();
    }
    const float lt = s.l + __shfl_xor(s.l, 32), inv = 1.0f / lt;
    LAS float* xch = (LAS float*)lds;
    if (map == 1) {
        const float f = inv * lam;
#pragma unroll
        for (int db = 0; db < 4; ++db)
#pragma unroll
            for (int r = 0; r < 16; ++r) xch[(qs * 64 + db * 16 + r) * 64 + lane] = s.O[db][r] * f;
    }
    __syncthreads();
    if (map == 0) {
        float ss = 0.f;
#pragma unroll
        for (int db = 0; db < 4; ++db)
#pragma unroll
            for (int r = 0; r < 16; ++r) { const float v = s.O[db][r] * inv - xch[(qs * 64 + db * 16 + r) * 64 + lane]; s.O[db][r] = v; ss += v * v; }
        ss += __shfl_xor(ss, 32);
        const float rs = rsqrtf(ss * (1.0f / 128.0f) + RMS_EPS) * post;
        bf16_t* op = OUT + (size_t)(b * SEQ + qw0 + l32) * DM + 512 + h * 128;
#pragma unroll
        for (int db = 0; db < 4; ++db)
#pragma unroll
            for (int g4 = 0; g4 < 4; ++g4) {
                const int d0 = 32 * db + 8 * g4 + 4 * hi;
                const f32x4 gv = *(const f32x4*)(subg + d0);
                u32x2 w; w.x = cvt_pk_bf16(s.O[db][4 * g4 + 0] * rs * gv[0], s.O[db][4 * g4 + 1] * rs * gv[1]);
                w.y = cvt_pk_bf16(s.O[db][4 * g4 + 2] * rs * gv[2], s.O[db][4 * g4 + 3] * rs * gv[3]);
                *(u32x2*)(op + d0) = w;
            }
    }
    __syncthreads();
}

constexpr int SKP = 144, SVP = 192, SV0 = 256 * SKP;
__device__ __forceinline__ void swa_unit(const bf16_t* PROJ, bf16_t* OUT, int b, int kvh, int n, const float* sinks, LAS char* lds) {
    int tid_ = threadIdx.x; asm volatile("" : "+v"(tid_));
    const int tid = tid_, lane = tid & 63, wave = __builtin_amdgcn_readfirstlane(tid >> 6), l32 = lane & 31, hi = lane >> 5;
    {
        const int ch = tid & 7, r0 = tid >> 3;
#pragma unroll
        for (int i = 0; i < 4; ++i) {
            const int row = r0 + 64 * i, pos = n * 128 - 128 + row;
            if (pos >= 0) {
                const bf16_t* src = PROJ + (size_t)(b * SEQ + pos) * INC + kvh * 64 + ch * 8;
                const u32x4 kv = *(const u32x4*)(src + C_KA), vv = *(const u32x4*)(src + C_VA);
                *(LAS u32x4*)(lds + row * SKP + ch * 16) = kv; *(LAS u32x4*)(lds + SV0 + row * SVP + ch * 16) = vv;
            }
        }
    }
    __syncthreads();
    for (int task = wave; task < 16; task += 8) {
        const int g = task >> 2, sb = task & 3, hq = kvh * 4 + g;
        const float slope2 = exp2f(-(float)(hq + 1)) * LOG2E, c32 = 32.f * slope2;
        f32x16 cval;
#pragma unroll
        for (int r = 0; r < 16; ++r) cval[r] = slope2 * (float)klocal(r, hi);
        bf16x8 qf[4];
        const size_t tok = (size_t)(b * SEQ + n * 128 + 32 * sb + l32);
        { const bf16_t* qp = PROJ + tok * INC + C_QA + hq * 64 + hi * 8;
#pragma unroll
          for (int ks = 0; ks < 4; ++ks) qf[ks] = *(const bf16x8*)(qp + ks * 16); }
        St<2> s;
#pragma unroll
        for (int db = 0; db < 2; ++db)
#pragma unroll
            for (int r = 0; r < 16; ++r) s.O[db][r] = 0.f;
        s.M = -1e30f; s.l = 0.f;
        const int kb_lo = (n == 0) ? 4 : sb, kb_hi = sb + 4;
        for (int kb = kb_lo; kb <= kb_hi; kb += 2) {
            const int nb = (kb + 1 <= kb_hi) ? 2 : 1;
            const int m0 = (kb == sb) ? 2 : ((kb == kb_hi) ? 1 : 0), m1 = (kb + 1 == kb_hi) ? 1 : 0;
            step<2>(s, qf, cval, c32, slope2 * (float)(32 * kb - (128 + 32 * sb)), lds, SKP, lds + SV0, SVP, 32 * kb, nb, m0, m1, lane);
        }
        const float sk = fast_exp2(sinks[hq] * LOG2E + slope2 * (float)l32 - s.M);
        const float lt = s.l + __shfl_xor(s.l, 32) + sk, inv = 1.0f / lt;
        bf16_t* op = OUT + tok * DM + hq * 64;
#pragma unroll
        for (int db = 0; db < 2; ++db)
#pragma unroll
            for (int g4 = 0; g4 < 4; ++g4) {
                const int d0 = 32 * db + 8 * g4 + 4 * hi;
                u32x2 w; w.x = cvt_pk_bf16(s.O[db][4 * g4 + 0] * inv, s.O[db][4 * g4 + 1] * inv); w.y = cvt_pk_bf16(s.O[db][4 * g4 + 2] * inv, s.O[db][4 * g4 + 3] * inv);
                *(u32x2*)(op + d0) = w;
            }
    }
    __syncthreads();
}
}


#define XB_TMO      128
#define XB_XCNT(j)  (256  + 64 * (j))
#define XB_XSUB(j)  (1280 + 64 * (j))
#define XB_XGEN(j)  (2304 + 64 * (j))
#define XB_TOP      3328
#define XB_TOPGEN   3392
#define XCD_BAR_WORDS 3456
#define XB_SPIN_CAP (1u << 18)
__device__ __forceinline__ unsigned xb_ld(unsigned* p)              { return __hip_atomic_load(p, __ATOMIC_RELAXED, __HIP_MEMORY_SCOPE_AGENT); }
__device__ __forceinline__ unsigned xb_add(unsigned* p, unsigned v) { return __hip_atomic_fetch_add(p, v, __ATOMIC_RELAXED, __HIP_MEMORY_SCOPE_AGENT); }
__device__ __forceinline__ unsigned xb_xcc_id() { return (unsigned)__builtin_amdgcn_s_getreg((3 << 11) | 20) & 0xFu; }
#define XB_SPIN(cond, bar) do { unsigned _sp = 0; while (cond) { __builtin_amdgcn_s_sleep(1); \
    if ((++_sp & 255u) == 0u) { if (xb_ld(&(bar)[XB_TMO])) break; if (_sp > XB_SPIN_CAP) { atomicAdd(&(bar)[XB_TMO], 1u); break; } } } } while (0)
struct XcdBarrier { unsigned* bar; unsigned x; volatile LAS unsigned* st; };
__device__ __forceinline__ XcdBarrier xcd_barrier_post(unsigned* bar, volatile LAS unsigned* st) {
    XcdBarrier b; b.bar = bar; b.x = xb_xcc_id(); b.st = st;
    if (threadIdx.x == 0) (void)xb_add(&bar[XB_XCNT(b.x)], 1u);
    return b;
}
__device__ __forceinline__ void xcd_barrier_complete(unsigned* bar, unsigned x, unsigned& nloc, unsigned& nx) {
    const unsigned G = gridDim.x * gridDim.y * gridDim.z;
    unsigned sum, cnt, mine, sp = 0u;
    for (;;) {
        sum = 0u; cnt = 0u; mine = 0u;
#pragma unroll
        for (unsigned j = 0; j < 16; ++j) { const unsigned c = xb_ld(&bar[XB_XCNT(j)]); sum += c; cnt += (c > 0u) ? 1u : 0u; mine = (j == x) ? c : mine; }
        if (sum == G) break;
        __builtin_amdgcn_s_sleep(1);
        if ((++sp & 255u) == 0u) { if (xb_ld(&bar[XB_TMO])) break; if (sp > XB_SPIN_CAP) { atomicAdd(&bar[XB_TMO], 1u); break; } }
    }
    nloc = mine > 0u ? mine : 1u; nx = cnt > 0u ? cnt : 1u;
}
__device__ __forceinline__ void xcd_barrier(const XcdBarrier& b) {
    asm volatile("s_waitcnt vmcnt(0)" ::: "memory");
    __syncthreads();
    if (threadIdx.x == 0) {
        unsigned* bar = b.bar;
        __builtin_amdgcn_s_waitcnt(0);
        unsigned nloc = b.st[0], nx = b.st[1];
        if (nloc == 0u) { xcd_barrier_complete(bar, b.x, nloc, nx); b.st[0] = nloc; b.st[1] = nx; }
        const unsigned old = xb_add(&bar[XB_XSUB(b.x)], 1u);
        const unsigned gen = old / nloc;
        if (old + 1u == (gen + 1u) * nloc) {
            __builtin_amdgcn_fence(__ATOMIC_RELEASE, "agent");
            asm volatile("s_waitcnt vmcnt(0)" ::: "memory");
            const unsigned og = xb_add(&bar[XB_TOP], 1u);
            const unsigned tg = og / nx;
            if (og + 1u == (tg + 1u) * nx) xb_add(&bar[XB_TOPGEN], 1u);
            else XB_SPIN(xb_ld(&bar[XB_TOPGEN]) == tg, bar);
            __builtin_amdgcn_fence(__ATOMIC_ACQUIRE, "agent");
            xb_add(&bar[XB_XGEN(b.x)], 1u);
            asm volatile("s_waitcnt vmcnt(0)" ::: "memory");
        } else {
            XB_SPIN(xb_ld(&bar[XB_XGEN(b.x)]) == gen, bar);
            __builtin_amdgcn_fence(__ATOMIC_ACQUIRE, "agent");
            asm volatile("s_waitcnt vmcnt(0)" ::: "memory");
        }
    }
    __syncthreads();
}

struct Params {
    const float *x, *c, *w_ada, *b_ada, *norm1_g, *w_in, *sinks, *dlam, *subg, *w_bs, *w_bd, *w_out, *norm2_g, *w_up, *conv_w, *conv_b, *w_down, *final_g;
    float* out; unsigned char* ws;
    int ph_lo, ph_hi;
};

__device__ __forceinline__ float wave_sum(float v) {
#pragma unroll
    for (int o = 1; o < 64; o <<= 1) v += __shfl_xor(v, o);
    return v;
}
__device__ __forceinline__ unsigned f2bf(float f) { unsigned u = __builtin_bit_cast(unsigned, f); return (u + 0x7fffu + ((u >> 16) & 1u)) >> 16; }
__device__ __forceinline__ unsigned pk2(float lo, float hi) { return f2bf(lo) | (f2bf(hi) << 16); }

__device__ __forceinline__ void transpose_item(const float* W, int ldw, int k0, int n0, bf16_t* WT, int ldt, int drow0, int kcol0, LAS float* scr, int lane) {
#pragma unroll 8
    for (int i = 0; i < 32; ++i) { const int kk = 2 * i + (lane >> 5); scr[kk * 33 + (lane & 31)] = W[(size_t)(k0 + kk) * ldw + n0 + (lane & 31)]; }
    asm volatile("s_waitcnt lgkmcnt(0)" ::: "memory");
    const int c = lane & 7;
#pragma unroll
    for (int j = 0; j < 4; ++j) { const int n = (lane >> 3) + 8 * j; const LAS float* s = scr + (8 * c) * 33 + n;
        u32x4 o; o.x = pk2(s[0 * 33], s[1 * 33]); o.y = pk2(s[2 * 33], s[3 * 33]); o.z = pk2(s[4 * 33], s[5 * 33]); o.w = pk2(s[6 * 33], s[7 * 33]);
        *(u32x4*)(WT + (size_t)(drow0 + n) * ldt + kcol0 + 8 * c) = o; }
    asm volatile("s_waitcnt lgkmcnt(0)" ::: "memory");
}

__device__ __forceinline__ void norm_phase(const float* xin, bf16_t* H, const float* g, const float* shift, const float* scale, int gw, int ngw, int lane) {
    asm volatile("" : "+v"(lane));
    for (int chunk = gw; chunk < NTOK / 8; chunk += ngw) {
        const int m0 = chunk * 8, b = m0 / SEQ;
        f32x4 G[4], Sv[4];
#pragma unroll
        for (int j = 0; j < 4; ++j) { const int k = 4 * lane + 256 * j; const f32x4 gg = *(const f32x4*)(g + k), sc = *(const f32x4*)(scale + (size_t)b * 6 * DM + k);
            G[j] = gg * (sc + 1.0f); Sv[j] = *(const f32x4*)(shift + (size_t)b * 6 * DM + k); }
        for (int rr = 0; rr < 8; ++rr) {
            const float* xr = xin + (size_t)(m0 + rr) * DM;
            f32x4 v[4]; float ss = 0.f;
#pragma unroll
            for (int j = 0; j < 4; ++j) { v[j] = *(const f32x4*)(xr + 4 * lane + 256 * j); ss += (v[j].x * v[j].x + v[j].y * v[j].y) + (v[j].z * v[j].z + v[j].w * v[j].w); }
            const float rstd = rsqrtf(wave_sum(ss) * (1.0f / DM) + RMS_EPS);
            bf16_t* hr = H + (size_t)(m0 + rr) * DM;
#pragma unroll
            for (int j = 0; j < 4; ++j) { const f32x4 o = v[j] * rstd * G[j] + Sv[j]; u32x2 w; w.x = cvt_pk_bf16(o[0], o[1]); w.y = cvt_pk_bf16(o[2], o[3]); *(u32x2*)(hr + 4 * lane + 256 * j) = w; }
        }
    }
}

__global__ void __launch_bounds__(512) fwd_mega(Params p) {
    extern __shared__ __attribute__((aligned(16))) unsigned char lds_raw[];
    LAS unsigned char* lds = (LAS unsigned char*)lds_raw;
    cg::grid_group grid = cg::this_grid();
    const int tid = threadIdx.x, lane = tid & 63, wave = __builtin_amdgcn_readfirstlane(tid >> 6);
    const int G = gridDim.x, bid = blockIdx.x;
    const int gw = bid * 8 + wave, ngw = G * 8;
    unsigned char* ws = p.ws;
    float* lamv = (float*)(ws + WS_LAM);
    float* mod = (float*)(ws + WS_MOD);
    bf16_t* Hb = (bf16_t*)(ws + WS_H); bf16_t* Ob = (bf16_t*)(ws + WS_O); bf16_t* MGb = (bf16_t*)(ws + WS_MG);
    bf16_t* PROJ = (bf16_t*)(ws + WS_PROJ); bf16_t* ACT = (bf16_t*)(ws + WS_ACT);
    float* X = p.out;
    int phase = 0;
#define RUN(k) (p.ph_lo <= (k) && (k) < p.ph_hi)
#define SEAM(k) do { if (RUN(k) && RUN((k) + 1)) xcd_barrier(bar); } while (0)
    unsigned* barw = (unsigned*)(ws + WS_BAR);
    volatile LAS unsigned* MISC = (volatile LAS unsigned*)(lds + MISC_OFF);
    if (tid < 2) MISC[tid] = 0u;
    if (bid == 0) for (int i = tid; i < XCD_BAR_WORDS; i += 512) barw[i] = 0u;
    __syncthreads();
    XcdBarrier bar; bar.bar = barw; bar.x = 0; bar.st = MISC;

    if (RUN(phase)) {
        if (bid == 0 && tid < DEPTH) {
            const float* lp = p.dlam + tid * 4 * 64; float s1 = 0.f, s2 = 0.f;
            for (int i = 0; i < 64; ++i) { s1 += lp[i] * lp[64 + i]; s2 += lp[128 + i] * lp[192 + i]; }
            lamv[tid] = expf(s1) - expf(s2) + (0.8f - 0.6f * expf(-0.3f * (float)tid));
        }
        {
            LAS float* cs = (LAS float*)lds;
            LAS float* red = (LAS float*)(lds + 16384);
            for (int i = tid; i < NBATCH * DM; i += 512) { const float v = p.c[i]; cs[i] = v / (1.0f + expf(-v)); }
            __syncthreads();
            for (int it = bid; it < DEPTH * 96; it += G) {
                const int l = it / 96, j0 = (it % 96) * 64;
                const float* wp = p.w_ada + (size_t)l * DM * 6 * DM + (size_t)(128 * wave) * 6 * DM + j0 + lane;
                float a0 = 0.f, a1 = 0.f, a2 = 0.f, a3 = 0.f;
#pragma unroll 8
                for (int k = 0; k < 128; ++k) { const float w = wp[(size_t)k * 6 * DM]; const int kk = 128 * wave + k;
                    a0 += cs[kk] * w; a1 += cs[DM + kk] * w; a2 += cs[2 * DM + kk] * w; a3 += cs[3 * DM + kk] * w; }
                red[(wave * 4 + 0) * 64 + lane] = a0; red[(wave * 4 + 1) * 64 + lane] = a1; red[(wave * 4 + 2) * 64 + lane] = a2; red[(wave * 4 + 3) * 64 + lane] = a3;
                __syncthreads();
                if (tid < 256) { const int b = tid >> 6, j = tid & 63; float sacc = p.b_ada[l * 6 * DM + j0 + j];
                    for (int w = 0; w < 8; ++w) sacc += red[(w * 4 + b) * 64 + j];
                    mod[((size_t)l * NBATCH + b) * 6 * DM + j0 + j] = sacc; }
                __syncthreads();
            }
        }
        {
            LAS float* scr = (LAS float*)(lds + wave * 16384);
            constexpr int I_IN = 16 * (INC / 32), I_BS = 8 * 32, I_OUT = 16 * 32, I_UP = 16 * (UPN / 32), I_DN = (DFF / 64) * 32;
            constexpr int I_L = I_IN + 2 * I_BS + I_OUT + I_UP + I_DN;
            for (int it = gw; it < DEPTH * I_L; it += ngw) {
                const int l = it / I_L; int r = it % I_L;
                bf16_t* wl = (bf16_t*)(ws + WS_W + (size_t)l * W_LAYER);
                if (r < I_IN) { const int nblk = INC / 32, kb = r / nblk, nb = r % nblk;
                    transpose_item(p.w_in + (size_t)l * DM * INC, INC, 64 * kb, 32 * nb, (bf16_t*)((char*)wl + W_IN), DM, 32 * nb, 64 * kb, scr, lane); continue; } r -= I_IN;
                if (r < I_BS) { const int kb = r / 32, nb = r % 32;
                    transpose_item(p.w_bs + (size_t)l * 512 * DM, DM, 64 * kb, 32 * nb, (bf16_t*)((char*)wl + W_BR), DM, 32 * nb, 64 * kb, scr, lane); continue; } r -= I_BS;
                if (r < I_BS) { const int kb = r / 32, nb = r % 32;
                    transpose_item(p.w_bd + (size_t)l * 512 * DM, DM, 64 * kb, 32 * nb, (bf16_t*)((char*)wl + W_BR), DM, 32 * nb, 512 + 64 * kb, scr, lane); continue; } r -= I_BS;
                if (r < I_OUT) { const int kb = r / 32, nb = r % 32;
                    transpose_item(p.w_out + (size_t)l * DM * DM, DM, 64 * kb, 32 * nb, (bf16_t*)((char*)wl + W_OUT), DM, 32 * nb, 64 * kb, scr, lane); continue; } r -= I_OUT;
                if (r < I_UP) { const int nblk = UPN / 32, kb = r / nblk, nb = r % nblk; const int n0 = 32 * nb;
                    const int drow = (n0 < DFF) ? ((n0 / 128) * 256 + (n0 % 128)) : (((n0 - DFF) / 128) * 256 + 128 + ((n0 - DFF) % 128));
                    transpose_item(p.w_up + (size_t)l * DM * UPN, UPN, 64 * kb, n0, (bf16_t*)((char*)wl + W_UP), DM, drow, 64 * kb, scr, lane); continue; } r -= I_UP;
                { const int kb = r / 32, nb = r % 32;
                    transpose_item(p.w_down + (size_t)l * DFF * DM, DM, 64 * kb, 32 * nb, (bf16_t*)((char*)wl + W_DN), DFF, 32 * nb, 64 * kb, scr, lane); }
            }
        }
        __syncthreads();
    }
    grid.sync();
    bar = xcd_barrier_post(barw, MISC);
    ++phase;

    for (int l = 0; l < DEPTH; ++l) {
        const float* modl = mod + (size_t)l * NBATCH * 6 * DM;
        const unsigned char* wl = ws + WS_W + (size_t)l * W_LAYER;
        const float* xin = (l == 0) ? p.x : X;
        if (RUN(phase)) norm_phase(xin, Hb, p.norm1_g + l * DM, modl + 0 * DM, modl + 1 * DM, gw, ngw, lane);
        SEAM(phase); ++phase;
        if (RUN(phase)) {
            pg8::Gemm g{Hb, (const bf16_t*)(wl + W_IN), DM, DM, DM}; pg8::StaticOrder S; S.init(NTOK / 256, INC / 256, G, bid, 0);
            pg8::EpiInProj E{PROJ};
            pg8::gemm_phase<pg8::EpiInProj, pg8::StaticOrder>(lds, g, S, E);
        }
        SEAM(phase); ++phase;
        if (RUN(phase)) {
            for (int u = bid; u < 256; u += G) att::swa_unit(PROJ, Ob, u >> 6, (u >> 5) & 1, u & 31, p.sinks + l * 8, (LAS char*)lds);
            const float lam = lamv[l], post = 1.0f - (0.8f - 0.6f * expf(-0.3f * (float)l));
            for (int u = bid; u < 256; u += G) {
                const int bh = u >> 4, j = u & 15;
                att::diff_unit(PROJ, Ob, bh >> 2, bh & 3, j, lam, post, p.subg + l * 128, (LAS char*)lds);
                att::diff_unit(PROJ, Ob, bh >> 2, bh & 3, 31 - j, lam, post, p.subg + l * 128, (LAS char*)lds);
            }
        }
        SEAM(phase); ++phase;
        if (RUN(phase)) {
            pg8::Gemm g{Ob, (const bf16_t*)(wl + W_BR), DM, DM, 512}; pg8::StaticOrder S; S.init(NTOK / 256, DM / 256, G, bid, 2);
            pg8::EpiMerge E{PROJ, MGb};
            pg8::gemm_phase<pg8::EpiMerge, pg8::StaticOrder>(lds, g, S, E);
        }
        SEAM(phase); ++phase;
        if (RUN(phase)) {
            pg8::Gemm g{MGb, (const bf16_t*)(wl + W_OUT), DM, DM, DM}; pg8::StaticOrder S; S.init(NTOK / 256, DM / 256, G, bid, 0);
            pg8::EpiRes E{xin, X, modl + 2 * DM};
            pg8::gemm_phase<pg8::EpiRes, pg8::StaticOrder>(lds, g, S, E);
        }
        SEAM(phase); ++phase;
        if (RUN(phase)) norm_phase(X, Hb, p.norm2_g + l * DM, modl + 3 * DM, modl + 4 * DM, gw, ngw, lane);
        SEAM(phase); ++phase;
        if (RUN(phase)) {
            pg8::Gemm g{Hb, (const bf16_t*)(wl + W_UP), DM, DM, DM}; pg8::StaticOrder S; S.init(NBATCH * UP_MT, UPN / 256, G, bid, 1);
            pg8::EpiUp E{ACT, p.conv_w + (size_t)l * 3 * DFF, p.conv_b + (size_t)l * DFF, (LAS float*)(lds + HALO_OFF)};
            pg8::gemm_phase<pg8::EpiUp, pg8::StaticOrder>(lds, g, S, E);
        }
        SEAM(phase); ++phase;
        if (RUN(phase)) {
            pg8::Gemm g{ACT, (const bf16_t*)(wl + W_DN), DFF, DFF, DFF}; pg8::StaticOrder S; S.init(NTOK / 256, DM / 256, G, bid, 0);
            pg8::EpiRes E{X, X, modl + 5 * DM};
            pg8::gemm_phase<pg8::EpiRes, pg8::StaticOrder>(lds, g, S, E);
        }
        SEAM(phase); ++phase;
    }
    if (RUN(phase)) {
        for (int m = gw; m < NTOK; m += ngw) {
            float* xr = X + (size_t)m * DM;
            f32x4 v[4]; float ss = 0.f;
#pragma unroll
            for (int j = 0; j < 4; ++j) { v[j] = *(const f32x4*)(xr + 4 * lane + 256 * j); ss += (v[j].x * v[j].x + v[j].y * v[j].y) + (v[j].z * v[j].z + v[j].w * v[j].w); }
            const float rstd = rsqrtf(wave_sum(ss) * (1.0f / DM) + RMS_EPS);
#pragma unroll
            for (int j = 0; j < 4; ++j) { const f32x4 gg = *(const f32x4*)(p.final_g + 4 * lane + 256 * j); *(f32x4*)(xr + 4 * lane + 256 * j) = v[j] * rstd * gg; }
        }
    }
#undef RUN
#undef SEAM
}

constexpr int N_PHASES = 1 + DEPTH * 8 + 1;

extern "C" void kernel_launch(void* const* d_in, const int* in_sizes, int n_in, void* d_out, int out_size, void* d_ws, size_t ws_size, hipStream_t stream) {
    static int grid = 0;
    if (grid == 0) {
        if (n_in != 18 || in_sizes[0] != NTOK * DM || out_size != NTOK * DM || ws_size < WS_END) {
            fprintf(stderr, "kernel_launch: unexpected shapes (n_in %d, in0 %d, out %d, ws %zu); nothing launched\n", n_in, n_in > 0 ? in_sizes[0] : -1, out_size, ws_size); grid = -1; return; }
        int dev = 0, cus = 0, per_cu = 0;
        if (hipGetDevice(&dev) != hipSuccess || hipDeviceGetAttribute(&cus, hipDeviceAttributeMultiprocessorCount, dev) != hipSuccess) { grid = -1; return; }
        if (hipFuncSetAttribute((const void*)fwd_mega, hipFuncAttributeMaxDynamicSharedMemorySize, LDS_BYTES) != hipSuccess) { fprintf(stderr, "kernel_launch: hipFuncSetAttribute failed\n"); grid = -1; return; }
        if (hipOccupancyMaxActiveBlocksPerMultiprocessor(&per_cu, (const void*)fwd_mega, 512, LDS_BYTES) != hipSuccess || per_cu < 1) { fprintf(stderr, "kernel_launch: occupancy query gave %d\n", per_cu); per_cu = 1; }
        (void)hipGetLastError();
        grid = cus * 1;
    }
    if (grid < 0) return;
    Params p{};
    const float** pp = (const float**)&p;
    for (int i = 0; i < 18; ++i) pp[i] = (const float*)d_in[i];
    p.out = (float*)d_out; p.ws = (unsigned char*)d_ws; p.ph_lo = 0; p.ph_hi = N_PHASES;
    void* args[] = {&p};
    hipError_t e = hipLaunchCooperativeKernel((const void*)fwd_mega, dim3(grid), dim3(512), args, LDS_BYTES, stream);
    if (e != hipSuccess) fprintf(stderr, "cooperative launch failed: %s (grid %d)\n", hipGetErrorString(e), grid);
}
```
